# Optimizing an MI355X kernel written in HIP

```python
import jax
import jax.numpy as jnp
from jax import lax
import numpy as np

D_MODEL = 1024
BATCH = 8
SEQ = 2048
DEPTH = 1
DEC_BATCH = 128
DEC_SEQ = 4
PAST_LEN = 16384
PAGE_SIZE = 128

HEAD_DIM = 64
A_Q_HEADS = 8
A_KV_HEADS = 2
A_GROUP = A_Q_HEADS // A_KV_HEADS
A_WINDOW = 128
B_DIL = ((128, 1), (512, 4), (2048, 16))
B_SLOTS = 4
B_HEADS = B_SLOTS * len(B_DIL)
BLK = 128
ROPE_THETA = 10000.0
D_FF = ((8 * D_MODEL // 3 + 127) // 128) * 128
CONV_W = 3
ALPHA = (2 * DEPTH) ** 0.25
BETA = (8 * DEPTH) ** -0.25
LN_EPS = 1e-5
NEG = -1e30
SCALE = HEAD_DIM ** -0.5
A_Q = A_Q_HEADS * HEAD_DIM
A_KV = A_KV_HEADS * HEAD_DIM
B_W = B_HEADS * HEAD_DIM
N_PROJ = A_Q + 2 * A_KV + 3 * B_W + 2 * D_MODEL
SPLIT_POINTS = (A_Q, A_Q + A_KV, A_Q + 2 * A_KV, A_Q + 2 * A_KV + B_W,
                A_Q + 2 * A_KV + 2 * B_W, A_Q + 2 * A_KV + 3 * B_W,
                A_Q + 2 * A_KV + 3 * B_W + D_MODEL)

kernel_name = 'hybrid_swa_sink_dilated_convffn_step'


def _layernorm(x, g, b):
    xf = x.astype(jnp.float32)
    mu = jnp.mean(xf, axis=-1, keepdims=True)
    var = jnp.mean(jnp.square(xf - mu), axis=-1, keepdims=True)
    return ((xf - mu) * lax.rsqrt(var + LN_EPS) * g + b).astype(x.dtype)


def _rope(x, pos):
    half = HEAD_DIM // 2
    inv = ROPE_THETA ** (-jnp.arange(half, dtype=jnp.float32) / half)
    ang = pos.astype(jnp.float32)[:, None] * inv[None, :]
    cos = jnp.cos(ang)[:, None, :]
    sin = jnp.sin(ang)[:, None, :]
    xf = x.astype(jnp.float32)
    x1, x2 = xf[..., :half], xf[..., half:]
    return jnp.concatenate([x1 * cos - x2 * sin, x2 * cos + x1 * sin], axis=-1).astype(x.dtype)


def _project(x, w_in):
    n, t, _ = x.shape
    qa, ka, va, qb, kb, vb, ga, gb = jnp.split(x @ w_in, SPLIT_POINTS, axis=-1)
    heads = lambda z: z.reshape(n, t, -1, HEAD_DIM)
    return heads(qa), heads(ka), heads(va), heads(qb), heads(kb), heads(vb), ga, gb


def _sink_logits(sink_a):
    return sink_a.astype(jnp.float32).reshape(A_KV_HEADS, A_GROUP, 1, 1)


def _sink_softmax(s, sink):
    m = jnp.maximum(jnp.max(s, axis=-1, keepdims=True), sink)
    e = jnp.exp(s - m)
    return e / (jnp.sum(e, axis=-1, keepdims=True) + jnp.exp(sink - m))


def _softmax_lse(s):
    m = jnp.max(s, axis=-1, keepdims=True)
    e = jnp.exp(s - m)
    den = jnp.sum(e, axis=-1, keepdims=True)
    return e / den, (m + jnp.log(den))[..., 0]


def _blocks(x, nb):
    pad = [(0, 0), (0, nb * BLK - x.shape[1])] + [(0, 0)] * (x.ndim - 2)
    x = jnp.pad(x, pad)
    return x.reshape(x.shape[0], nb, BLK, *x.shape[2:])


def _with_prev(xb):
    prev = jnp.pad(xb[:, :-1], [(0, 0), (1, 0)] + [(0, 0)] * (xb.ndim - 2))
    return jnp.concatenate([prev, xb], axis=2)


def _band_scores(q, k, window):
    n, t = q.shape[:2]
    nb = -(-t // BLK)
    qb = _blocks(q, nb)
    kc = _with_prev(_blocks(k, nb))
    s = jnp.einsum('nbqkgd,nbskd->nbkgqs', qb, kc, preferred_element_type=jnp.float32) * SCALE
    blk = jnp.arange(nb)[:, None, None]
    qi = jnp.arange(BLK)[None, :, None] + BLK
    si = jnp.arange(2 * BLK)[None, None, :]
    dist = qi - si
    mask = (dist >= 0) & (dist < window) & ((blk > 0) | (si >= BLK))
    return jnp.where(mask[None, :, None, None], s, NEG)


def _band_values(p, v):
    n, t = v.shape[:2]
    nb = p.shape[1]
    vc = _with_prev(_blocks(v, nb))
    o = jnp.einsum('nbkgqs,nbskd->nbqkgd', p.astype(v.dtype), vc)
    return o.reshape(n, nb * BLK, *o.shape[3:])[:, :t]


def _band_rows(r, t):
    n, nb = r.shape[:2]
    return r.transpose(0, 1, 4, 2, 3).reshape(n, nb * BLK, *r.shape[2:4])[:, :t]


def _stride_split(x, d):
    n, t = x.shape[:2]
    x = x.reshape(n, t // d, d, *x.shape[2:]).swapaxes(1, 2)
    return x.reshape(n * d, t // d, *x.shape[3:])


def _stride_merge(x, n, d):
    x = x.reshape(n, d, *x.shape[1:]).swapaxes(1, 2)
    return x.reshape(n, d * x.shape[1], *x.shape[3:])


def _combine_groups(outs, lses):
    o = jnp.stack(outs)
    wts = jax.nn.softmax(jnp.stack(lses), axis=0)
    ob = jnp.sum(wts[..., None] * o.astype(jnp.float32), axis=0).astype(o.dtype)
    return ob.reshape(ob.shape[0], ob.shape[1], B_SLOTS * HEAD_DIM)


def _merge(oa, ob, ga, gb, w_br_a, w_br_b, w_o):
    m = jax.nn.sigmoid(ga) * (oa @ w_br_a) + jax.nn.sigmoid(gb) * (ob @ w_br_b)
    return m @ w_o


def _prompt_mixer(x, w_in, sink_a, w_br_a, w_br_b, w_o):
    n, t, _ = x.shape
    pos = jnp.arange(t, dtype=jnp.int32)
    qa, ka, va, qb, kb, vb, ga, gb = _project(x, w_in)
    qa, ka, qb, kb = _rope(qa, pos), _rope(ka, pos), _rope(qb, pos), _rope(kb, pos)
    s = _band_scores(qa.reshape(n, t, A_KV_HEADS, A_GROUP, HEAD_DIM), ka, A_WINDOW)
    p = _sink_softmax(s, _sink_logits(sink_a))
    oa = _band_values(p, va).reshape(n, t, A_Q)
    la = min(A_WINDOW, t)
    kv_a = jnp.stack([ka[:, t - la:], va[:, t - la:]], axis=2)
    outs, lses, kv_b = [], [], []
    for g, (win, dil) in enumerate(B_DIL):
        hs = slice(g * B_SLOTS, (g + 1) * B_SLOTS)
        qg, kg, vg = (_stride_split(z[:, :, hs], dil) for z in (qb, kb, vb))
        s = _band_scores(qg[:, :, :, None], kg, win // dil)
        p, lse = _softmax_lse(s)
        outs.append(_stride_merge(_band_values(p, vg)[:, :, :, 0], n, dil))
        lses.append(_stride_merge(_band_rows(lse, t // dil)[..., 0], n, dil))
        lb = min(win, t)
        kv_b.append(jnp.stack([kb[:, t - lb:, hs], vb[:, t - lb:, hs]], axis=2))
    ob = _combine_groups(outs, lses)
    return _merge(oa, ob, ga, gb, w_br_a, w_br_b, w_o), kv_a, kv_b


def _sample_mixer(x, cache_a, caches_b, w_in, sink_a, w_br_a, w_br_b, w_o):
    n, t, _ = x.shape
    qpos = PAST_LEN + jnp.arange(t, dtype=jnp.int32)
    qa, ka, va, qb, kb, vb, ga, gb = _project(x, w_in)
    qa, ka, qb, kb = _rope(qa, qpos), _rope(ka, qpos), _rope(qb, qpos), _rope(kb, qpos)
    la = cache_a.shape[1]
    k_all = jnp.concatenate([cache_a[:, :, 0], ka], axis=1)
    v_all = jnp.concatenate([cache_a[:, :, 1], va], axis=1)
    kpos = PAST_LEN - la + jnp.arange(la + t, dtype=jnp.int32)
    dist = qpos[:, None] - kpos[None, :]
    mask = (dist >= 0) & (dist < A_WINDOW)
    s = jnp.einsum('nqkgd,nskd->nkgqs', qa.reshape(n, t, A_KV_HEADS, A_GROUP, HEAD_DIM), k_all,
                   preferred_element_type=jnp.float32) * SCALE
    p = _sink_softmax(jnp.where(mask, s, NEG), _sink_logits(sink_a))
    oa = jnp.einsum('nkgqs,nskd->nqkgd', p.astype(v_all.dtype), v_all).reshape(n, t, A_Q)
    kv_a = jnp.stack([ka, va], axis=2)
    outs, lses, kv_b = [], [], []
    for g, ((win, dil), cache) in enumerate(zip(B_DIL, caches_b)):
        hs = slice(g * B_SLOTS, (g + 1) * B_SLOTS)
        lb = cache.shape[1]
        kg_new, vg_new = kb[:, :, hs], vb[:, :, hs]
        k_all = jnp.concatenate([cache[:, :, 0], kg_new], axis=1)
        v_all = jnp.concatenate([cache[:, :, 1], vg_new], axis=1)
        kp = qpos[:, None] - dil * jnp.arange(win // dil, dtype=jnp.int32)[None, :]
        idx = jnp.maximum(kp - (PAST_LEN - lb), 0)
        s = jnp.einsum('nqhd,nqjhd->nhqj', qb[:, :, hs], k_all[:, idx],
                       preferred_element_type=jnp.float32) * SCALE
        p, lse = _softmax_lse(jnp.where(kp >= 0, s, NEG))
        outs.append(jnp.einsum('nhqj,nqjhd->nqhd', p.astype(v_all.dtype), v_all[:, idx]))
        lses.append(lse.transpose(0, 2, 1))
        kv_b.append(jnp.stack([kg_new, vg_new], axis=2))
    ob = _combine_groups(outs, lses)
    return _merge(oa, ob, ga, gb, w_br_a, w_br_b, w_o), kv_a, kv_b


def _post_layer(x, mix, conv_prev, ln1_g, ln1_b, w_up, conv_w, conv_b, w_down, ln2_g, ln2_b):
    h = _layernorm(ALPHA * x + mix, ln1_g, ln1_b)
    u, v = jnp.split(h @ w_up, 2, axis=-1)
    if conv_prev is None:
        conv_prev = jnp.zeros((u.shape[0], CONV_W - 1, D_FF), u.dtype)
    ext = jnp.concatenate([conv_prev.astype(u.dtype), u], axis=1)
    t = u.shape[1]
    a = sum((conv_w[j] * ext[:, j:j + t] for j in range(CONV_W)), conv_b)
    f = (jax.nn.gelu(a, approximate=False) * v) @ w_down
    return _layernorm(ALPHA * h + f, ln2_g, ln2_b), ext[:, t:]


def setup_inputs(seed: int = 0) -> dict:
    key = jax.random.key(seed)
    ks = jax.random.split(key, 20)

    def nrm(k, shape, scale=1.0):
        return jax.random.normal(k, shape, jnp.float32) * scale

    la = min(A_WINDOW, PAST_LEN)
    lb1, lb2, lb3 = (min(w, PAST_LEN) for w, _ in B_DIL)
    bo = B_SLOTS * HEAD_DIM
    return {
        'x_prompt': nrm(ks[0], (BATCH, SEQ, D_MODEL)),
        'x_sample': nrm(ks[1], (DEC_BATCH, DEC_SEQ, D_MODEL)),
        'cache_a': nrm(ks[2], (DEPTH, DEC_BATCH, la, 2, A_KV_HEADS, HEAD_DIM)),
        'cache_b1': nrm(ks[3], (DEPTH, DEC_BATCH, lb1, 2, B_SLOTS, HEAD_DIM)),
        'cache_b2': nrm(ks[4], (DEPTH, DEC_BATCH, lb2, 2, B_SLOTS, HEAD_DIM)),
        'cache_b3': nrm(ks[5], (DEPTH, DEC_BATCH, lb3, 2, B_SLOTS, HEAD_DIM)),
        'state_conv': nrm(ks[6], (DEPTH, DEC_BATCH, CONV_W - 1, D_FF)),
        'w_in': nrm(ks[7], (DEPTH, D_MODEL, N_PROJ), D_MODEL ** -0.5),
        'sink_a': nrm(ks[8], (DEPTH, A_Q_HEADS), 0.5),
        'w_br_a': nrm(ks[9], (DEPTH, A_Q, D_MODEL), A_Q ** -0.5),
        'w_br_b': nrm(ks[10], (DEPTH, bo, D_MODEL), bo ** -0.5),
        'w_o': nrm(ks[11], (DEPTH, D_MODEL, D_MODEL), BETA * D_MODEL ** -0.5),
        'ln1_g': 1.0 + nrm(ks[12], (DEPTH, D_MODEL), 0.02),
        'ln1_b': nrm(ks[13], (DEPTH, D_MODEL), 0.02),
        'w_up': nrm(ks[14], (DEPTH, D_MODEL, 2 * D_FF), D_MODEL ** -0.5),
        'conv_w': nrm(ks[15], (DEPTH, CONV_W, D_FF), CONV_W ** -0.5),
        'conv_b': nrm(ks[16], (DEPTH, D_FF), 0.02),
        'w_down': nrm(ks[17], (DEPTH, D_FF, D_MODEL), BETA * D_FF ** -0.5),
        'ln2_g': 1.0 + nrm(ks[18], (DEPTH, D_MODEL), 0.02),
        'ln2_b': nrm(ks[19], (DEPTH, D_MODEL), 0.02),
    }


def reference(x_prompt, x_sample, cache_a, cache_b1, cache_b2, cache_b3, state_conv,
              w_in, sink_a, w_br_a, w_br_b, w_o, ln1_g, ln1_b,
              w_up, conv_w, conv_b, w_down, ln2_g, ln2_b):
    hp, hs = x_prompt, x_sample
    a_p, a_s, b_p, b_s, c_p, c_s = [], [], [], [], [], []
    for l in range(DEPTH):
        ffn = (ln1_g[l], ln1_b[l], w_up[l], conv_w[l], conv_b[l], w_down[l], ln2_g[l], ln2_b[l])
        mix_p, kva_p, kvb_p = _prompt_mixer(hp, w_in[l], sink_a[l], w_br_a[l], w_br_b[l], w_o[l])
        mix_s, kva_s, kvb_s = _sample_mixer(hs, cache_a[l], (cache_b1[l], cache_b2[l], cache_b3[l]),
                                            w_in[l], sink_a[l], w_br_a[l], w_br_b[l], w_o[l])
        hp, conv_p = _post_layer(hp, mix_p, None, *ffn)
        hs, conv_s = _post_layer(hs, mix_s, state_conv[l], *ffn)
        a_p.append(kva_p)
        a_s.append(kva_s)
        b_p.append(kvb_p)
        b_s.append(kvb_s)
        c_p.append(conv_p)
        c_s.append(conv_s)
    y_prompt, y_sample = hp, hs
    cache_a_prompt = jnp.stack(a_p)
    cache_a_sample = jnp.stack(a_s)
    cache_b1_prompt = jnp.stack([b[0] for b in b_p])
    cache_b1_sample = jnp.stack([b[0] for b in b_s])
    cache_b2_prompt = jnp.stack([b[1] for b in b_p])
    cache_b2_sample = jnp.stack([b[1] for b in b_s])
    cache_b3_prompt = jnp.stack([b[2] for b in b_p])
    cache_b3_sample = jnp.stack([b[2] for b in b_s])
    state_conv_prompt = jnp.stack(c_p)
    state_conv_sample = jnp.stack(c_s)
    return (y_prompt, y_sample, cache_a_prompt, cache_a_sample, cache_b1_prompt, cache_b1_sample,
            cache_b2_prompt, cache_b2_sample, cache_b3_prompt, cache_b3_sample,
            state_conv_prompt, state_conv_sample)
```

```cpp
#include <hip/hip_runtime.h>
#include <hip/hip_cooperative_groups.h>
#include <cstdio>
#include <cstdint>
#include <cmath>
namespace cg = cooperative_groups;

constexpr int TP = 16384, TS = 512, TT = TP + TS;
constexpr int DM = 1024, NPROJ = 5120, FF = 2816, NUP = 2 * FF;
constexpr int SEQ = 2048, PAST = 16384;
constexpr float ALPHA = 1.189207115002721f;
constexpr float LN_EPS = 1e-5f;
constexpr float QSCALE = 0.125f * 1.4426950408889634f;
constexpr float LOG2E = 1.4426950408889634f, LN2 = 0.6931471805599453f;
constexpr size_t O_Y = 0;
constexpr size_t O_CA_P = (size_t)TT * DM;
constexpr size_t O_CA_S = O_CA_P + 8 * 128 * 2 * 2 * 64;
constexpr size_t O_CB1_P = O_CA_S + 128 * 4 * 2 * 2 * 64;
constexpr size_t O_CB1_S = O_CB1_P + 8 * 128 * 512;
constexpr size_t O_CB2_P = O_CB1_S + 128 * 4 * 512;
constexpr size_t O_CB2_S = O_CB2_P + 8 * 512 * 512;
constexpr size_t O_CB3_P = O_CB2_S + 128 * 4 * 512;
constexpr size_t O_CB3_S = O_CB3_P + (size_t)8 * 2048 * 512;
constexpr size_t O_SC_P = O_CB3_S + 128 * 4 * 512;
constexpr size_t O_SC_S = O_SC_P + 8 * 2 * FF;
constexpr size_t O_END = O_SC_S + 128 * 2 * FF;
constexpr size_t MiB = 1u << 20;
constexpr size_t WS_CTL = 0, WS_ROPE = 1 * MiB, WS_WIN = 2 * MiB, WS_WBRA = 12 * MiB, WS_WBRB = 13 * MiB, WS_WO = 14 * MiB, WS_WUP = 16 * MiB, WS_WDN = 27 * MiB;
constexpr size_t WS_XB = 34 * MiB, WS_PROJ = 68 * MiB, WS_OA = 234 * MiB, WS_OBG = 252 * MiB, WS_LSE = 277 * MiB, WS_OB = 278 * MiB;
constexpr size_t WS_T1 = 288 * MiB, WS_M = 322 * MiB, WS_Z1 = 356 * MiB, WS_HB = 422 * MiB, WS_UV = 456 * MiB, WS_G = 638 * MiB, WS_END = 730 * MiB;

namespace pg8 {
#define PG8_LAS __attribute__((address_space(3)))
typedef unsigned short bf16_t;
typedef short bf16x8 __attribute__((ext_vector_type(8)));
typedef float f32x4 __attribute__((ext_vector_type(4)));
typedef unsigned u32x4 __attribute__((ext_vector_type(4)));
constexpr int BM = 256, BK = 64, HALF = 128, HTB = HALF * BK * 2  , STAGE_BYTES = 8 * HTB, NXCD = 8, WGM = 8;

__host__ __device__ __forceinline__ int lds_byte(int r, int c) { const int st = (r >> 4) * 2 + (c >> 5), rr = r & 15, cc = c & 31, ob = rr * 64 + cc * 2; return st * 1024 + (ob ^ (((ob >> 9) & 1) << 5)); }
__host__ __device__ __forceinline__ void stage_rc(int b, int& R, int& C) { const int st = b / 1024, sb = b % 1024, swz = sb ^ (((sb >> 9) & 1) << 5); R = (st >> 1) * 16 + swz / 64; C = (st & 1) * 32 + (swz % 64) / 2; }
__host__ __device__ __forceinline__ int perm32(int rho) { const int n = rho >> 4, i = rho & 15; return 8 * (i >> 2) + 4 * n + (i & 3); }

struct Unit { int pm, pn; };
struct Gemm { const bf16_t* A; const bf16_t* Bt; int M, N, K; };

struct StaticOrder {
    int nM, nN, nwg, G, c;
    __host__ __device__ void init(int M, int N, int G_, int c_) { nM = M / BM; nN = N / BM; nwg = nM * nN; G = G_; c = c_; }
    __host__ __device__ bool next(int i, Unit& u) const {
        const long L = (long)i * G + c; if (L >= nwg) return false;
        int wgid = (int)L; { const int q = nwg / NXCD, r = nwg % NXCD, xcd = wgid % NXCD, off = wgid / NXCD; wgid = (xcd < r ? xcd * (q + 1) : r * (q + 1) + (xcd - r) * q) + off; }
        const int nig = WGM * nN, gid = wgid / nig, fm = gid * WGM, gsz = (nM - fm) < WGM ? (nM - fm) : WGM;
        u.pm = fm + ((wgid % nig) % gsz); u.pn = (wgid % nig) / gsz; return true;
    }
    __device__ __forceinline__ void a_ready(const Unit&) const {}
    __device__ __forceinline__ void done(const Unit&) const {}
};

__device__ __forceinline__ unsigned cvt_pk_bf16(float lo, float hi) { unsigned r; asm volatile("v_cvt_pk_bf16_f32 %0, %1, %2" : "=v"(r) : "v"(lo), "v"(hi)); return r; }
typedef float f32x2 __attribute__((ext_vector_type(2)));
__device__ __forceinline__ f32x2 gelu_pk(f32x2 v) {
    const f32x2 av = __builtin_elementwise_abs(v), d = av * 0.2316418882f + 1.0f;
    f32x2 t; t.x = __builtin_amdgcn_rcpf(d.x); t.y = __builtin_amdgcn_rcpf(d.y);
    f32x2 q = t * 0.5307027145f + (-0.7265760135f); q = q * t + 0.7107068705f; q = q * t + (-0.142248368f); q = q * t + 0.127414796f; q = q * t;
    const f32x2 s = (v * v) * (-0.72134752044f);
    f32x2 e; e.x = __builtin_amdgcn_exp2f(s.x); e.y = __builtin_amdgcn_exp2f(s.y);
    const f32x2 m = v * (q * e), r = v - m;
    f32x2 o; o.x = v.x < 0.f ? m.x : r.x; o.y = v.y < 0.f ? m.y : r.y; return o;
}

typedef unsigned u32x2 __attribute__((ext_vector_type(2)));
__device__ __forceinline__ float bf_lo(unsigned w) { return __uint_as_float(w << 16); }
__device__ __forceinline__ float bf_hi(unsigned w) { return __uint_as_float(w & 0xffff0000u); }
__device__ __forceinline__ float sigmoidf_(float x) { return __builtin_amdgcn_rcpf(1.0f + __builtin_amdgcn_exp2f(-x * 1.4426950408889634f)); }

struct EpiProj {
    static constexpr bool PERM = false, AFTER_DRAIN = false;
    bf16_t* P; const float* rope; float* out;
    __device__ __forceinline__ void operator()(const f32x4 (&acc)[2][2][4][2], const Unit& u, int wr, int wc, int fr, int fq) const {
#pragma unroll
        for (int bj = 0; bj < 2; ++bj) {
            const int hs = 4 * u.pn + 2 * bj + (wc >> 1);
            const int d0 = 16 * (wc & 1) + 4 * fq;
            const bool is_q = (hs < 8) || (hs >= 12 && hs < 24);
            const bool is_k = (hs >= 8 && hs < 10) || (hs >= 24 && hs < 36);
            const bool is_v = (hs >= 10 && hs < 12) || (hs >= 36 && hs < 48);
            const bool do_rope = is_q || is_k;
#pragma unroll
            for (int ai = 0; ai < 2; ++ai)
#pragma unroll
                for (int m = 0; m < 4; ++m) {
                    const int row = u.pm * BM + ai * HALF + wr * 64 + m * 16 + fr;
                    f32x4 v0 = acc[ai][bj][m][0], v1 = acc[ai][bj][m][1];
                    if (do_rope) {
                        const int pidx = row < TP ? (row & (SEQ - 1)) : SEQ + (row & 3);
                        const f32x4* rp = (const f32x4*)(rope + ((size_t)pidx * 32 + d0) * 2);
                        const f32x4 c01 = rp[0], c23 = rp[1];
                        f32x4 o0, o1;
                        o0[0] = v0[0] * c01[0] - v1[0] * c01[1]; o1[0] = v1[0] * c01[0] + v0[0] * c01[1];
                        o0[1] = v0[1] * c01[2] - v1[1] * c01[3]; o1[1] = v1[1] * c01[2] + v0[1] * c01[3];
                        o0[2] = v0[2] * c23[0] - v1[2] * c23[1]; o1[2] = v1[2] * c23[0] + v0[2] * c23[1];
                        o0[3] = v0[3] * c23[2] - v1[3] * c23[3]; o1[3] = v1[3] * c23[2] + v0[3] * c23[3];
                        v0 = o0; v1 = o1;
                    }
                    if (is_k || is_v) {
                        float* dst = nullptr;
                        const int kv = is_v ? 1 : 0;
                        if (hs < 12) {
                            const int kh = (hs - 8) & 1;
                            if (row < TP) { const int b = row >> 11, t = row & (SEQ - 1); if (t >= SEQ - 128) dst = out + O_CA_P + ((((size_t)b * 128 + (t - (SEQ - 128))) * 2 + kv) * 2 + kh) * 64; }
                            else { const int r = row - TP; dst = out + O_CA_S + (((size_t)r * 2 + kv) * 2 + kh) * 64; }
                        } else {
                            const int hb = (hs - 24) % 12, g = hb >> 2, s = hb & 3, lb = 128 << (2 * g);
                            const size_t op = g == 0 ? O_CB1_P : (g == 1 ? O_CB2_P : O_CB3_P), os = g == 0 ? O_CB1_S : (g == 1 ? O_CB2_S : O_CB3_S);
                            if (row < TP) { const int b = row >> 11, t = row & (SEQ - 1); if (t >= SEQ - lb) dst = out + op + ((((size_t)b * lb + (t - (SEQ - lb))) * 2 + kv) * 4 + s) * 64; }
                            else { const int r = row - TP; dst = out + os + (((size_t)r * 2 + kv) * 4 + s) * 64; }
                        }
                        if (dst) { *(f32x4*)(dst + d0) = v0; *(f32x4*)(dst + d0 + 32) = v1; }
                    }
                    if (is_q) { v0 = v0 * QSCALE; v1 = v1 * QSCALE; }
                    bf16_t* pp = P + (size_t)row * NPROJ + hs * 64 + d0;
                    u32x2 w0, w1; w0.x = cvt_pk_bf16(v0[0], v0[1]); w0.y = cvt_pk_bf16(v0[2], v0[3]); w1.x = cvt_pk_bf16(v1[0], v1[1]); w1.y = cvt_pk_bf16(v1[2], v1[3]);
                    *(u32x2*)pp = w0; *(u32x2*)(pp + 32) = w1;
                }
        }
    }
};

template <int SECOND> struct EpiGate {
    static constexpr bool PERM = true, AFTER_DRAIN = false;
    const bf16_t* P; const bf16_t* T1in; bf16_t* O;
    __device__ __forceinline__ void operator()(const f32x4 (&acc)[2][2][4][2], const Unit& u, int wr, int wc, int fr, int fq) const {
        const int row0 = u.pm * BM + wr * 64 + fr, col0 = u.pn * BM + wc * 32 + 8 * fq;
#pragma unroll
        for (int ai = 0; ai < 2; ++ai)
#pragma unroll
            for (int m = 0; m < 4; ++m) {
                const int row = row0 + ai * HALF + m * 16;
#pragma unroll
                for (int bj = 0; bj < 2; ++bj) {
                    const int col = col0 + bj * HALF;
                    const u32x4 gw = *(const u32x4*)(P + (size_t)row * NPROJ + (SECOND ? 4096 : 3072) + col);
                    f32x4 v0 = acc[ai][bj][m][0], v1 = acc[ai][bj][m][1];
                    v0[0] *= sigmoidf_(bf_lo(gw.x)); v0[1] *= sigmoidf_(bf_hi(gw.x)); v0[2] *= sigmoidf_(bf_lo(gw.y)); v0[3] *= sigmoidf_(bf_hi(gw.y));
                    v1[0] *= sigmoidf_(bf_lo(gw.z)); v1[1] *= sigmoidf_(bf_hi(gw.z)); v1[2] *= sigmoidf_(bf_lo(gw.w)); v1[3] *= sigmoidf_(bf_hi(gw.w));
                    if (SECOND) { const u32x4 tw = *(const u32x4*)(T1in + (size_t)row * DM + col);
                        v0[0] += bf_lo(tw.x); v0[1] += bf_hi(tw.x); v0[2] += bf_lo(tw.y); v0[3] += bf_hi(tw.y);
                        v1[0] += bf_lo(tw.z); v1[1] += bf_hi(tw.z); v1[2] += bf_lo(tw.w); v1[3] += bf_hi(tw.w); }
                    u32x4 w; w.x = cvt_pk_bf16(v0[0], v0[1]); w.y = cvt_pk_bf16(v0[2], v0[3]); w.z = cvt_pk_bf16(v1[0], v1[1]); w.w = cvt_pk_bf16(v1[2], v1[3]);
                    *(u32x4*)(O + (size_t)row * DM + col) = w;
                }
                asm volatile("" ::: "memory");
            }
    }
};

struct EpiZ1 {
    static constexpr bool PERM = false, AFTER_DRAIN = false;
    const float* xp; const float* xs; float* Z;
    __device__ __forceinline__ void operator()(const f32x4 (&acc)[2][2][4][2], const Unit& u, int wr, int wc, int fr, int fq) const {
        const int row0 = u.pm * BM + wr * 64 + fr, col0 = u.pn * BM + wc * 32 + 4 * fq;
#pragma unroll
        for (int ai = 0; ai < 2; ++ai)
#pragma unroll
            for (int m = 0; m < 4; ++m) {
                const int row = row0 + ai * HALF + m * 16;
                const float* xr = row < TP ? xp + (size_t)row * DM : xs + (size_t)(row - TP) * DM;
#pragma unroll
                for (int bj = 0; bj < 2; ++bj)
#pragma unroll
                    for (int n = 0; n < 2; ++n) { const int col = col0 + bj * HALF + n * 16;
                        const f32x4 xv = *(const f32x4*)(xr + col);
                        *(f32x4*)(Z + (size_t)row * DM + col) = xv * ALPHA + acc[ai][bj][m][n]; }
            }
    }
};

struct EpiUV {
    static constexpr bool PERM = true, AFTER_DRAIN = false;
    bf16_t* UV; float* out;
    __device__ __forceinline__ void operator()(const f32x4 (&acc)[2][2][4][2], const Unit& u, int wr, int wc, int fr, int fq) const {
        const int row0 = u.pm * BM + wr * 64 + fr, ct0 = wc * 32 + 8 * fq;
#pragma unroll
        for (int ai = 0; ai < 2; ++ai)
#pragma unroll
            for (int m = 0; m < 4; ++m) {
                const int row = row0 + ai * HALF + m * 16;
#pragma unroll
                for (int bj = 0; bj < 2; ++bj) {
                    const f32x4 v0 = acc[ai][bj][m][0], v1 = acc[ai][bj][m][1];
                    u32x4 w; w.x = cvt_pk_bf16(v0[0], v0[1]); w.y = cvt_pk_bf16(v0[2], v0[3]); w.z = cvt_pk_bf16(v1[0], v1[1]); w.w = cvt_pk_bf16(v1[2], v1[3]);
                    *(u32x4*)(UV + (size_t)row * NUP + u.pn * BM + bj * HALF + ct0) = w;
                    if (bj == 0) {
                        float* dst = nullptr; const int ucol = u.pn * HALF + ct0;
                        if (row < TP) { const int b = row >> 11, t = row & (SEQ - 1); if (t >= SEQ - 2) dst = out + O_SC_P + ((size_t)b * 2 + (t - (SEQ - 2))) * FF + ucol; }
                        else { const int r = row - TP, n = r >> 2, qi = r & 3; if (qi >= 2) dst = out + O_SC_S + ((size_t)n * 2 + (qi - 2)) * FF + ucol; }
                        if (dst) { *(f32x4*)dst = v0; *(f32x4*)(dst + 4) = v1; }
                    }
                }
            }
    }
};

struct EpiZ2 {
    static constexpr bool PERM = false, AFTER_DRAIN = false;
    const bf16_t* HB; float* Y;
    __device__ __forceinline__ void operator()(const f32x4 (&acc)[2][2][4][2], const Unit& u, int wr, int wc, int fr, int fq) const {
        const int row0 = u.pm * BM + wr * 64 + fr, col0 = u.pn * BM + wc * 32 + 4 * fq;
#pragma unroll
        for (int ai = 0; ai < 2; ++ai)
#pragma unroll
            for (int m = 0; m < 4; ++m) {
                const int row = row0 + ai * HALF + m * 16;
#pragma unroll
                for (int bj = 0; bj < 2; ++bj)
#pragma unroll
                    for (int n = 0; n < 2; ++n) { const int col = col0 + bj * HALF + n * 16;
                        const u32x2 hw = *(const u32x2*)(HB + (size_t)row * DM + col);
                        f32x4 hv; hv[0] = bf_lo(hw.x); hv[1] = bf_hi(hw.x); hv[2] = bf_lo(hw.y); hv[3] = bf_hi(hw.y);
                        *(f32x4*)(Y + (size_t)row * DM + col) = hv * ALPHA + acc[ai][bj][m][n]; }
            }
    }
};

template <class Epi, class Sched, bool ALIGN_EPI = false, bool SP2 = false>
__device__ __forceinline__ void gemm_phase(PG8_LAS unsigned char* lds, const Gemm g, const Sched& S, const Epi& E) {
    const int tid = threadIdx.x, wid = __builtin_amdgcn_readfirstlane(tid >> 6), lane = tid & 63, wr = wid >> 2, wc = wid & 3, fr = lane & 15, fq = lane >> 4;
    int K = g.K; asm volatile("" : "+s"(K));
    const int nt = K / BK;
    unsigned voffA[2], voffB[2];
#pragma unroll
    for (int i = 0; i < 2; ++i) { int R, C; stage_rc(tid * 16 + i * 8192, R, C); const int Rb = Epi::PERM ? ((R & ~31) + perm32(R & 31)) : R;
        voffA[i] = (unsigned)(R * K + C) * 2u; voffB[i] = (unsigned)(Rb * K + C) * 2u; }
    const size_t kstep = (size_t)(BK * 2);
    const size_t hstep = (size_t)HALF * K * 2;
    const size_t tstep = 2 * hstep;
    const unsigned ldsw = (unsigned)wid * 1024u;
    const int aoff = lds_byte(wr * 64 + fr, fq * 8), boff = lds_byte(wc * 32 + fr, fq * 8);
#define PG8_SA(b, h) (((b) * 2 + (h)) * HTB)
#define PG8_SB(b, h) ((4 + (b) * 2 + (h)) * HTB)
#define PG8_STAGE(bufoff, gbase, voff) do { _Pragma("unroll") for (int _i = 0; _i < 2; ++_i) \
        __builtin_amdgcn_global_load_lds((const unsigned*)((const char*)(gbase) + (voff)[_i]), (PG8_LAS unsigned*)(lds + (bufoff) + ldsw + _i * 8192), 16, 0, 0); } while (0)
#define PG8_LDA(dst, b, h) do { _Pragma("unroll") for (int m = 0; m < 4; ++m) _Pragma("unroll") for (int k = 0; k < 2; ++k) dst[m][k] = *(const PG8_LAS bf16x8*)(lds + PG8_SA(b, h) + aoff + m * 2048 + k * 1024); } while (0)
#define PG8_LDB(dst, b, h) do { _Pragma("unroll") for (int n = 0; n < 2; ++n) _Pragma("unroll") for (int k = 0; k < 2; ++k) dst[n][k] = *(const PG8_LAS bf16x8*)(lds + PG8_SB(b, h) + boff + n * 2048 + k * 1024); } while (0)
#define PG8_MMA(ai, bj, At, Bt) do { __builtin_amdgcn_s_setprio(1); _Pragma("unroll") for (int m = 0; m < 4; ++m) _Pragma("unroll") for (int n = 0; n < 2; ++n) _Pragma("unroll") for (int k = 0; k < 2; ++k) \
        acc[ai][bj][m][n] = __builtin_amdgcn_mfma_f32_16x16x32_bf16(Bt[n][k], At[m][k], acc[ai][bj][m][n], 0, 0, 0); __builtin_amdgcn_s_setprio(0); } while (0)
#define PG8_WAIT_V(n) asm volatile("s_waitcnt vmcnt(" #n ")" ::: "memory")
#define PG8_WAIT_L(n) asm volatile("s_waitcnt lgkmcnt(" #n ")" ::: "memory")
#define PG8_BAR __builtin_amdgcn_s_barrier()
#define PG8_SCHED __builtin_amdgcn_sched_barrier(0)
    Unit cur, nxt; int ui = 0;
    if (!S.next(0, cur)) return;
    f32x4 acc[2][2][4][2];
#pragma unroll
    for (int a = 0; a < 2; ++a)
#pragma unroll
        for (int b = 0; b < 2; ++b)
#pragma unroll
            for (int m = 0; m < 4; ++m)
#pragma unroll
                for (int n = 0; n < 2; ++n) acc[a][b][m][n] = (f32x4){0.f, 0.f, 0.f, 0.f};
    bf16x8 At[4][2], B0[2][2], B1[2][2];
    const char* cA = (const char*)g.A + (size_t)cur.pm * tstep; const char* cB = (const char*)g.Bt + (size_t)cur.pn * tstep;
    S.a_ready(cur);
    if constexpr (SP2) {
        PG8_STAGE(PG8_SB(0, 0), cB, voffB); PG8_STAGE(PG8_SB(0, 1), cB + hstep, voffB); PG8_STAGE(PG8_SA(0, 0), cA, voffA); PG8_STAGE(PG8_SA(0, 1), cA + hstep, voffA);
        if (wr == 1) PG8_BAR;
        PG8_WAIT_V(2); PG8_BAR;
        PG8_STAGE(PG8_SB(1, 0), cB + kstep, voffB); PG8_STAGE(PG8_SA(1, 0), cA + kstep, voffA); PG8_STAGE(PG8_SB(1, 1), cB + hstep + kstep, voffB);
        PG8_WAIT_V(6); PG8_BAR;
    } else {
        PG8_STAGE(PG8_SB(0, 0), cB, voffB); PG8_STAGE(PG8_SA(0, 0), cA, voffA); PG8_STAGE(PG8_SB(0, 1), cB + hstep, voffB); PG8_STAGE(PG8_SA(0, 1), cA + hstep, voffA);
        if (wr == 1) PG8_BAR;
        PG8_WAIT_V(4); PG8_BAR;
        PG8_STAGE(PG8_SB(1, 0), cB + kstep, voffB); PG8_STAGE(PG8_SA(1, 0), cA + kstep, voffA); PG8_STAGE(PG8_SB(1, 1), cB + hstep + kstep, voffB);
        PG8_WAIT_V(6); PG8_BAR;
    }
    for (;;) {
        const bool has_next = S.next(ui + 1, nxt);
        const char* nA = has_next ? (const char*)g.A + (size_t)nxt.pm * tstep : cA; const char* nB = has_next ? (const char*)g.Bt + (size_t)nxt.pn * tstep : cB;
        for (int t = 0; t < nt; t += 2) {
            const bool last = (t == nt - 2);
            const char* a1 = cA + (size_t)(t + 1) * kstep;
            const char* a2 = last ? nA : cA + (size_t)(t + 2) * kstep; const char* b2 = last ? nB : cB + (size_t)(t + 2) * kstep;
            const char* a3 = a2 + kstep; const char* b3 = b2 + kstep;
            if (last && has_next) S.a_ready(nxt);
            if constexpr (SP2) {
            PG8_LDB(B0, 0, 0); PG8_LDB(B1, 0, 1); PG8_SCHED; PG8_LDA(At, 0, 0); PG8_STAGE(PG8_SA(1, 1), a1 + hstep, voffA);
            PG8_WAIT_V(8); PG8_WAIT_L(0); PG8_BAR; PG8_MMA(0, 0, At, B0); PG8_MMA(0, 1, At, B1); PG8_BAR; PG8_SCHED;
            PG8_LDA(At, 0, 1); PG8_STAGE(PG8_SB(0, 0), b2, voffB); PG8_STAGE(PG8_SB(0, 1), b2 + hstep, voffB); PG8_STAGE(PG8_SA(0, 0), a2, voffA);
            PG8_WAIT_V(8); PG8_WAIT_L(0); PG8_BAR; PG8_MMA(1, 0, At, B0); PG8_MMA(1, 1, At, B1); PG8_BAR; PG8_SCHED;
            PG8_LDB(B0, 1, 0); PG8_LDB(B1, 1, 1); PG8_SCHED; PG8_LDA(At, 1, 0); PG8_STAGE(PG8_SA(0, 1), a2 + hstep, voffA);
            PG8_WAIT_V(8); PG8_WAIT_L(0); PG8_BAR; PG8_MMA(0, 0, At, B0); PG8_MMA(0, 1, At, B1); PG8_BAR; PG8_SCHED;
            PG8_LDA(At, 1, 1); PG8_STAGE(PG8_SB(1, 0), b3, voffB); PG8_STAGE(PG8_SB(1, 1), b3 + hstep, voffB); PG8_STAGE(PG8_SA(1, 0), a3, voffA);
            PG8_WAIT_V(8); PG8_WAIT_L(0); PG8_BAR; PG8_MMA(1, 0, At, B0); PG8_MMA(1, 1, At, B1); PG8_BAR; PG8_SCHED;
            } else {
            PG8_LDB(B0, 0, 0); PG8_SCHED; PG8_LDA(At, 0, 0); PG8_STAGE(PG8_SA(1, 1), a1 + hstep, voffA);
            PG8_WAIT_L(8); PG8_BAR; PG8_WAIT_L(0); PG8_MMA(0, 0, At, B0); PG8_BAR; PG8_SCHED;
            PG8_LDB(B1, 0, 1); PG8_STAGE(PG8_SB(0, 0), b2, voffB);
            PG8_BAR; PG8_WAIT_L(0); PG8_MMA(0, 1, At, B1); PG8_BAR;
            PG8_LDA(At, 0, 1); PG8_STAGE(PG8_SA(0, 0), a2, voffA);
            PG8_BAR; PG8_WAIT_L(0); PG8_MMA(1, 0, At, B0); PG8_BAR; PG8_SCHED;
            PG8_STAGE(PG8_SB(0, 1), b2 + hstep, voffB);
            PG8_WAIT_V(6); PG8_BAR; PG8_MMA(1, 1, At, B1); PG8_BAR;
            PG8_LDB(B0, 1, 0); PG8_SCHED; PG8_LDA(At, 1, 0); PG8_STAGE(PG8_SA(0, 1), a2 + hstep, voffA);
            PG8_WAIT_L(8); PG8_BAR; PG8_WAIT_L(0); PG8_MMA(0, 0, At, B0); PG8_BAR; PG8_SCHED;
            PG8_LDB(B1, 1, 1); PG8_STAGE(PG8_SB(1, 0), b3, voffB);
            PG8_BAR; PG8_WAIT_L(0); PG8_MMA(0, 1, At, B1); PG8_BAR;
            PG8_LDA(At, 1, 1); PG8_STAGE(PG8_SA(1, 0), a3, voffA);
            PG8_BAR; PG8_WAIT_L(0); PG8_MMA(1, 0, At, B0); PG8_BAR; PG8_SCHED;
            PG8_STAGE(PG8_SB(1, 1), b3 + hstep, voffB);
            PG8_WAIT_V(6); PG8_BAR; PG8_MMA(1, 1, At, B1); PG8_BAR;
            }
        }
        if constexpr (ALIGN_EPI) { if (wr == 0) PG8_BAR; }
        if constexpr (!Epi::AFTER_DRAIN) { E(acc, cur, wr, wc, fr, fq); S.done(cur); }
        if (!has_next) break;
#pragma unroll
        for (int a = 0; a < 2; ++a)
#pragma unroll
            for (int b = 0; b < 2; ++b)
#pragma unroll
                for (int m = 0; m < 4; ++m)
#pragma unroll
                    for (int n = 0; n < 2; ++n) acc[a][b][m][n] = (f32x4){0.f, 0.f, 0.f, 0.f};
        cur = nxt; cA = nA; cB = nB; ++ui;
        if constexpr (ALIGN_EPI) { if (wr == 1) PG8_BAR; }
    }
    PG8_WAIT_V(0);
    if constexpr (!ALIGN_EPI) { if (wr == 0) PG8_BAR; }
    PG8_BAR;
    if constexpr (Epi::AFTER_DRAIN) { E.fused(acc, cur, wr, wc, fr, fq, lds, wid, lane); S.done(cur); }
#undef PG8_SA
#undef PG8_SB
#undef PG8_STAGE
#undef PG8_LDA
#undef PG8_LDB
#undef PG8_MMA
#undef PG8_WAIT_V
#undef PG8_WAIT_L
#undef PG8_BAR
#undef PG8_SCHED
}
}

#define LAS __attribute__((address_space(3)))
typedef unsigned short bf16;
typedef float f32x4 __attribute__((ext_vector_type(4)));
typedef short bf16x8 __attribute__((ext_vector_type(8)));
typedef short s16x4 __attribute__((ext_vector_type(4)));
typedef unsigned u32x4 __attribute__((ext_vector_type(4)));
typedef unsigned u32x2 __attribute__((ext_vector_type(2)));
constexpr int NWAVES = 8, NTHREADS = 512;
constexpr int RING_BYTES = 131072, LDS_BYTES = 147456;
constexpr int NPHASE = 12;

__device__ __forceinline__ unsigned f2bf(float f) { unsigned u = __builtin_bit_cast(unsigned, f); return (u + 0x7fffu + ((u >> 16) & 1u)) >> 16; }
__device__ __forceinline__ unsigned pk2(float lo, float hi) { return f2bf(lo) | (f2bf(hi) << 16); }
__device__ __forceinline__ float bflo(unsigned w) { return __uint_as_float(w << 16); }
__device__ __forceinline__ float bfhi(unsigned w) { return __uint_as_float(w & 0xffff0000u); }
__device__ __forceinline__ float wave_sum(float v) {
#pragma unroll
    for (int o = 1; o < 64; o <<= 1) v += __shfl_xor(v, o);
    return v;
}
template <int CTRL> __device__ __forceinline__ float dppf(float v) { return __builtin_bit_cast(float, __builtin_amdgcn_update_dpp(0, __builtin_bit_cast(int, v), CTRL, 0xf, 0xf, true)); }
__device__ __forceinline__ float row16_sum(float v) {
    v += dppf<0xB1>(v);
    v += dppf<0x4E>(v);
    v += dppf<0x141>(v);
    v += dppf<0x140>(v);
    return v;
}

struct Args { const float* in[20]; float* out; unsigned char* ws; double inv_freq[32]; int ph_lo, ph_hi, coop, pad; };

template <int MAP> __device__ __forceinline__ int rowmap(int n) {
    if (MAP == 1) { const int blk = n >> 6, o = n & 63, nn = o >> 5, half = (o >> 4) & 1, q = o & 15; return (blk << 6) + 32 * half + 16 * nn + q; }
    if (MAP == 2) { return n < FF ? ((n >> 7) << 8) + (n & 127) : (((n - FF) >> 7) << 8) + 128 + ((n - FF) & 127); }
    return n;
}
template <int MAP> __device__ __forceinline__ void p0_transpose_item(const float* W, int K, int N, bf16* WT, LAS float* scr, int item, int lane) {
    const int nblk = N / 32, kb = item / nblk, nb = item % nblk, k0 = 64 * kb, n0 = 32 * nb;
#pragma unroll 8
    for (int i = 0; i < 32; ++i) { const int kk = 2 * i + (lane >> 5); scr[kk * 33 + (lane & 31)] = W[(size_t)(k0 + kk) * N + n0 + (lane & 31)]; }
    asm volatile("s_waitcnt lgkmcnt(0)" ::: "memory");
    const int c = lane & 7;
#pragma unroll
    for (int j = 0; j < 4; ++j) { const int n = (lane >> 3) + 8 * j; const LAS float* s = scr + (8 * c) * 33 + n;
        u32x4 o; o.x = pk2(s[0 * 33], s[1 * 33]); o.y = pk2(s[2 * 33], s[3 * 33]); o.z = pk2(s[4 * 33], s[5 * 33]); o.w = pk2(s[6 * 33], s[7 * 33]);
        *(u32x4*)(WT + (size_t)rowmap<MAP>(n0 + n) * K + k0 + 8 * c) = o; }
    asm volatile("s_waitcnt lgkmcnt(0)" ::: "memory");
}
__device__ __forceinline__ void p0_prologue(const Args& a, LAS unsigned char* lds, int gw, int NGW, int wave, int lane) {
    unsigned char* ws = a.ws;
    LAS float* scr = (LAS float*)(lds + wave * 16384);
    constexpr int I_IN = (DM / 64) * (NPROJ / 32), I_BA = (512 / 64) * (DM / 32), I_BB = (256 / 64) * (DM / 32), I_O = (DM / 64) * (DM / 32), I_UP = (DM / 64) * (NUP / 32), I_DN = (FF / 64) * (DM / 32);
    constexpr int NITEMS = I_IN + I_BA + I_BB + I_O + I_UP + I_DN;
    for (int it = gw; it < NITEMS; it += NGW) {
        int r = it;
        if (r < I_IN) { p0_transpose_item<1>(a.in[7], DM, NPROJ, (bf16*)(ws + WS_WIN), scr, r, lane); continue; } r -= I_IN;
        if (r < I_BA) { p0_transpose_item<0>(a.in[9], 512, DM, (bf16*)(ws + WS_WBRA), scr, r, lane); continue; } r -= I_BA;
        if (r < I_BB) { p0_transpose_item<0>(a.in[10], 256, DM, (bf16*)(ws + WS_WBRB), scr, r, lane); continue; } r -= I_BB;
        if (r < I_O) { p0_transpose_item<0>(a.in[11], DM, DM, (bf16*)(ws + WS_WO), scr, r, lane); continue; } r -= I_O;
        if (r < I_UP) { p0_transpose_item<2>(a.in[14], DM, NUP, (bf16*)(ws + WS_WUP), scr, r, lane); continue; } r -= I_UP;
        p0_transpose_item<0>(a.in[17], FF, DM, (bf16*)(ws + WS_WDN), scr, r, lane);
    }
    bf16* XB = (bf16*)(ws + WS_XB);
    for (int m = gw; m < TT; m += NGW) {
        const float* xr = m < TP ? a.in[0] + (size_t)m * DM : a.in[1] + (size_t)(m - TP) * DM;
        const f32x4* x4 = (const f32x4*)xr + lane; unsigned long long* o8 = (unsigned long long*)(XB + (size_t)m * DM) + lane;
#pragma unroll
        for (int j = 0; j < 4; ++j) { const f32x4 v = x4[64 * j]; o8[64 * j] = (unsigned long long)pk2(v[0], v[1]) | ((unsigned long long)pk2(v[2], v[3]) << 32); }
    }
    float* rope = (float*)(ws + WS_ROPE);
    for (int e = gw * 64 + lane; e < 2052 * 32; e += NGW * 64) {
        const int p = e >> 5, d = e & 31; const double pos = (double)(p < SEQ ? p : PAST + (p - SEQ));
        const double ang = pos * a.inv_freq[d];
        const double k = rint(ang * 0.15915494309189535);
        double r = fma(-k, 6.283185307179586, ang); r = fma(-k, 2.4492935982947064e-16, r);
        rope[2 * e] = (float)cos(r); rope[2 * e + 1] = (float)sin(r);
    }
}

namespace att {
constexpr int KP = 144, NROW = 272;
constexpr int LDS_K = 0, LDS_V = NROW * KP, LDS_END = 2 * NROW * KP;
static_assert(LDS_END <= RING_BYTES, "attention LDS");
__device__ __forceinline__ void stage_kv(const bf16* Kg, const bf16* Vg, long rstride, bool lowvalid, LAS unsigned char* lds, int tid) {
    const int ch = tid & 7;
#pragma unroll
    for (int it = 0; it < 4; ++it) {
        const int j = (tid >> 3) + 64 * it; const bool ok = lowvalid || j >= 128;
        u32x4 kv = (u32x4){0u, 0u, 0u, 0u}, vv = (u32x4){0u, 0u, 0u, 0u};
        if (ok) { kv = *(const u32x4*)(Kg + (long)j * rstride + ch * 8); vv = *(const u32x4*)(Vg + (long)j * rstride + ch * 8); }
        *(LAS u32x4*)(lds + LDS_K + j * KP + ch * 16) = kv; *(LAS u32x4*)(lds + LDS_V + j * KP + ch * 16) = vv;
    }
}
__device__ __forceinline__ void wave_attend(const LAS unsigned char* lds, int kb0, int ibase, int jmin, const bf16x8 (&qf)[2], float sink2, bool has_sink, f32x4 (&o)[4], float& mrow, float& lrow, int lane) {
    const int g = lane >> 4, ql = lane & 15;
    f32x4 st[5][2];
    const LAS unsigned char* kbase = lds + LDS_K + (kb0 + 8 * (ql >> 2) + (ql & 3)) * KP + 16 * g;
#pragma unroll
    for (int s = 0; s < 5; ++s)
#pragma unroll
        for (int t = 0; t < 2; ++t) {
            f32x4 acc = (f32x4){0.f, 0.f, 0.f, 0.f};
#pragma unroll
            for (int ks = 0; ks < 2; ++ks) { const bf16x8 kf = *(const LAS bf16x8*)(kbase + (32 * s + 4 * t) * KP + 64 * ks);
                acc = __builtin_amdgcn_mfma_f32_16x16x32_bf16(kf, qf[ks], acc, 0, 0, 0); }
            st[s][t] = acc;
        }
    float mx = -1e30f;
#pragma unroll
    for (int s = 0; s < 5; ++s)
#pragma unroll
        for (int t = 0; t < 2; ++t)
#pragma unroll
            for (int r = 0; r < 4; ++r) { const int j = kb0 + 32 * s + 8 * g + 4 * t + r, rel = j - (ibase + ql);
                const bool ok = rel >= 1 && rel <= 128 && j >= jmin; const float x = ok ? st[s][t][r] : -1e30f; st[s][t][r] = x; mx = fmaxf(mx, x); }
    mx = fmaxf(mx, __shfl_xor(mx, 16)); mx = fmaxf(mx, __shfl_xor(mx, 32));
    if (has_sink) mx = fmaxf(mx, sink2);
    float sum = 0.f; bf16x8 pf[5];
#pragma unroll
    for (int s = 0; s < 5; ++s) {
        float p[8];
#pragma unroll
        for (int t = 0; t < 2; ++t)
#pragma unroll
            for (int r = 0; r < 4; ++r) { p[4 * t + r] = __builtin_amdgcn_exp2f(st[s][t][r] - mx); sum += p[4 * t + r]; }
        u32x4 w; w.x = pk2(p[0], p[1]); w.y = pk2(p[2], p[3]); w.z = pk2(p[4], p[5]); w.w = pk2(p[6], p[7]);
        pf[s] = __builtin_bit_cast(bf16x8, w);
    }
    sum += __shfl_xor(sum, 16); sum += __shfl_xor(sum, 32);
    const float den = has_sink ? sum + __builtin_amdgcn_exp2f(sink2 - mx) : sum;
    const LAS unsigned char* vbase = lds + LDS_V + (kb0 + 8 * g + (ql >> 2)) * KP + 8 * (lane & 3);
#pragma unroll
    for (int c = 0; c < 4; ++c) {
        f32x4 acc = (f32x4){0.f, 0.f, 0.f, 0.f};
#pragma unroll
        for (int s = 0; s < 5; ++s) {
            const s16x4 lo = __builtin_bit_cast(s16x4, __builtin_amdgcn_ds_read_tr16_b64_v4i16((LAS s16x4*)(vbase + (32 * s) * KP + 32 * c)));
            const s16x4 hi = __builtin_bit_cast(s16x4, __builtin_amdgcn_ds_read_tr16_b64_v4i16((LAS s16x4*)(vbase + (32 * s + 4) * KP + 32 * c)));
            const bf16x8 vf = (bf16x8){lo[0], lo[1], lo[2], lo[3], hi[0], hi[1], hi[2], hi[3]};
            acc = __builtin_amdgcn_mfma_f32_16x16x32_bf16(vf, pf[s], acc, 0, 0, 0);
        }
        const float inv = 1.0f / den;
        o[c] = acc * inv;
    }
    mrow = mx; lrow = sum;
}

__device__ __forceinline__ void prompt_unit(const Args& a, LAS unsigned char* lds, int uidx, int tid, int wave, int lane) {
    unsigned char* ws = a.ws;
    const bf16* P = (const bf16*)(ws + WS_PROJ);
    int b, blk, dil, nq, qcol, kcol, vcol, grp = 0, slot = 0; bool isA;
    if (uidx < 256) { isA = true; b = uidx >> 5; blk = (uidx >> 1) & 15; const int kh = uidx & 1; dil = 1; nq = 4; qcol = kh * 256; kcol = 512 + kh * 64; vcol = 640 + kh * 64; }
    else { const int v = uidx - 256; isA = false; b = v / 192; const int rem = v % 192, hb = rem >> 4; blk = rem & 15; grp = hb >> 2; slot = hb & 3; dil = 1 << (2 * grp); nq = 1;
        qcol = 768 + hb * 64; kcol = 1536 + hb * 64; vcol = 2304 + hb * 64; }
    const int nbr = 16 / dil;
    const int rho = blk / nbr, beta = blk % nbr;
    const long tok0 = (long)b * SEQ + rho + (long)dil * 128 * (beta - 1);
    const long rstride = (long)dil * NPROJ;
    __syncthreads();
    stage_kv(P + tok0 * NPROJ + kcol, P + tok0 * NPROJ + vcol, rstride, beta > 0, lds, tid);
    __syncthreads();
    const int g = lane >> 4, ql = lane & 15;
    const long qtok = tok0 + (long)dil * (128 + 16 * wave + ql);
    const float* sink = a.in[8];
    for (int h = 0; h < nq; ++h) {
        const bf16* qp = P + qtok * NPROJ + qcol + h * 64 + 8 * g;
        bf16x8 qf[2]; qf[0] = *(const bf16x8*)qp; qf[1] = *(const bf16x8*)(qp + 32);
        f32x4 o[4]; float mrow, lrow;
        const float sk = isA ? sink[(qcol >> 6) + h] * LOG2E : -1e30f;
        wave_attend(lds, 16 * wave, 16 * wave, beta > 0 ? 0 : 128, qf, sk, isA, o, mrow, lrow, lane);
        if (isA) {
            bf16* op = (bf16*)(ws + WS_OA) + qtok * 512 + qcol + h * 64 + 4 * g;
#pragma unroll
            for (int c = 0; c < 4; ++c) { u32x2 w; w.x = pk2(o[c][0], o[c][1]); w.y = pk2(o[c][2], o[c][3]); *(u32x2*)(op + 16 * c) = w; }
        } else {
            bf16* op = (bf16*)(ws + WS_OBG) + ((size_t)grp * TT + qtok) * 256 + slot * 64 + 4 * g;
#pragma unroll
            for (int c = 0; c < 4; ++c) { u32x2 w; w.x = pk2(o[c][0], o[c][1]); w.y = pk2(o[c][2], o[c][3]); *(u32x2*)(op + 16 * c) = w; }
            if (g == 0) ((float*)(ws + WS_LSE))[((size_t)grp * TT + qtok) * 4 + slot] = LN2 * (mrow + __builtin_amdgcn_logf(lrow));
        }
    }
}

__device__ __forceinline__ void sample_task(const float* cache, const float* newrows, int lb, int dil, int qi, int rowf, int koff, int voff, f32x4 q, float& m, float& l, f32x4& o) {
#pragma unroll 4
    for (int j = 0; j < 128; ++j) {
        const int off = qi - dil * j;
        const float* rp = off >= 0 ? newrows + (size_t)off * rowf : cache + (size_t)(lb + off) * rowf;
        const f32x4 k4 = *(const f32x4*)(rp + koff), v4 = *(const f32x4*)(rp + voff);
        float s = (q[0] * k4[0] + q[1] * k4[1]) + (q[2] * k4[2] + q[3] * k4[3]);
        s = row16_sum(s);
        const float mn = fmaxf(m, s), sc = __builtin_amdgcn_exp2f(m - mn), p = __builtin_amdgcn_exp2f(s - mn);
        l = l * sc + p; o = o * sc + v4 * p; m = mn;
    }
}
__device__ __forceinline__ void sample_tasks(const Args& a, int gw, int NGW, int lane) {
    unsigned char* ws = a.ws; const bf16* P = (const bf16*)(ws + WS_PROJ);
    const int t = lane >> 4, dd = 4 * (lane & 15);
    for (int task = gw; task < 2560; task += NGW) {
        if (task < 1536) {
            const int grp = task % 3, nq = task / 3, n = nq >> 2, qi = nq & 3, lb = 128 << (2 * grp), dil = 1 << (2 * grp);
            const float* cache = a.in[3 + grp] + (size_t)n * lb * 512;
            const size_t os = grp == 0 ? O_CB1_S : (grp == 1 ? O_CB2_S : O_CB3_S);
            const float* newrows = a.out + os + (size_t)n * 4 * 512;
            const size_t row = (size_t)TP + nq;
            const u32x2 qw = *(const u32x2*)(P + row * NPROJ + 768 + (4 * grp + t) * 64 + dd);
            const f32x4 q = (f32x4){bflo(qw.x), bfhi(qw.x), bflo(qw.y), bfhi(qw.y)};
            float m = -1e30f, l = 0.f; f32x4 o = (f32x4){0.f, 0.f, 0.f, 0.f};
            sample_task(cache, newrows, lb, dil, qi, 512, 64 * t + dd, 256 + 64 * t + dd, q, m, l, o);
            o = o * (1.0f / l);
            u32x2 w; w.x = pk2(o[0], o[1]); w.y = pk2(o[2], o[3]);
            *(u32x2*)((bf16*)(ws + WS_OBG) + ((size_t)grp * TT + row) * 256 + t * 64 + dd) = w;
            if ((lane & 15) == 0) ((float*)(ws + WS_LSE))[((size_t)grp * TT + row) * 4 + t] = LN2 * (m + __builtin_amdgcn_logf(l));
        } else {
            const int v = task - 1536, half = v & 1, nq = v >> 1, n = nq >> 2, qi = nq & 3;
            const int kvh = t >> 1, qh = 4 * kvh + 2 * half + (t & 1);
            const float* cache = a.in[2] + (size_t)n * 128 * 256;
            const float* newrows = a.out + O_CA_S + (size_t)n * 4 * 256;
            const size_t row = (size_t)TP + nq;
            const u32x2 qw = *(const u32x2*)(P + row * NPROJ + qh * 64 + dd);
            const f32x4 q = (f32x4){bflo(qw.x), bfhi(qw.x), bflo(qw.y), bfhi(qw.y)};
            float m = a.in[8][qh] * LOG2E, l = 1.0f; f32x4 o = (f32x4){0.f, 0.f, 0.f, 0.f};
            sample_task(cache, newrows, 128, 1, qi, 256, 64 * kvh + dd, 128 + 64 * kvh + dd, q, m, l, o);
            o = o * (1.0f / l);
            u32x2 w; w.x = pk2(o[0], o[1]); w.y = pk2(o[2], o[3]);
            *(u32x2*)((bf16*)(ws + WS_OA) + row * 512 + qh * 64 + dd) = w;
        }
    }
}
}

__device__ __forceinline__ void combine_pass(const Args& a, int gtid, int NGT) {
    unsigned char* ws = a.ws; const bf16* OBG = (const bf16*)(ws + WS_OBG); const float* LSE = (const float*)(ws + WS_LSE); bf16* OB = (bf16*)(ws + WS_OB);
    for (int it = gtid; it < TT * 32; it += NGT) {
        const int row = it >> 5, c8 = (it & 31) * 8, slot = c8 >> 6;
        const float l0 = LSE[((size_t)0 * TT + row) * 4 + slot], l1 = LSE[((size_t)1 * TT + row) * 4 + slot], l2 = LSE[((size_t)2 * TT + row) * 4 + slot];
        const float mx = fmaxf(l0, fmaxf(l1, l2));
        float w0 = __expf(l0 - mx), w1 = __expf(l1 - mx), w2 = __expf(l2 - mx); const float inv = 1.0f / (w0 + w1 + w2); w0 *= inv; w1 *= inv; w2 *= inv;
        const u32x4 a0 = *(const u32x4*)(OBG + ((size_t)0 * TT + row) * 256 + c8), a1 = *(const u32x4*)(OBG + ((size_t)1 * TT + row) * 256 + c8), a2 = *(const u32x4*)(OBG + ((size_t)2 * TT + row) * 256 + c8);
        u32x4 r;
#pragma unroll
        for (int k = 0; k < 4; ++k) r[k] = pk2(w0 * bflo(a0[k]) + w1 * bflo(a1[k]) + w2 * bflo(a2[k]), w0 * bfhi(a0[k]) + w1 * bfhi(a1[k]) + w2 * bfhi(a2[k]));
        *(u32x4*)(OB + (size_t)row * 256 + c8) = r;
    }
}
__device__ __forceinline__ void ln_row(const float* zr, const float* gam, const float* bet, int lane, f32x4 (&y)[4]) {
    const f32x4* z4 = (const f32x4*)zr + lane; f32x4 v[4]; float s = 0.f;
#pragma unroll
    for (int j = 0; j < 4; ++j) { v[j] = z4[64 * j]; s += (v[j][0] + v[j][1]) + (v[j][2] + v[j][3]); }
    const float mean = wave_sum(s) * (1.f / DM); float s2 = 0.f;
#pragma unroll
    for (int j = 0; j < 4; ++j) { v[j] = v[j] - mean; s2 += (v[j][0] * v[j][0] + v[j][1] * v[j][1]) + (v[j][2] * v[j][2] + v[j][3] * v[j][3]); }
    const float rstd = 1.f / sqrtf(wave_sum(s2) * (1.f / DM) + LN_EPS);
#pragma unroll
    for (int j = 0; j < 4; ++j) { const f32x4 gv = ((const f32x4*)gam + lane)[64 * j], bv = ((const f32x4*)bet + lane)[64 * j]; y[j] = v[j] * rstd * gv + bv; }
}
__device__ __forceinline__ void ln1_pass(const Args& a, int gw, int NGW, int lane) {
    const float* Z = (const float*)(a.ws + WS_Z1); bf16* HB = (bf16*)(a.ws + WS_HB);
    for (int m = gw; m < TT; m += NGW) {
        f32x4 y[4]; ln_row(Z + (size_t)m * DM, a.in[12], a.in[13], lane, y);
        unsigned long long* o8 = (unsigned long long*)(HB + (size_t)m * DM) + lane;
#pragma unroll
        for (int j = 0; j < 4; ++j) o8[64 * j] = (unsigned long long)pk2(y[j][0], y[j][1]) | ((unsigned long long)pk2(y[j][2], y[j][3]) << 32);
    }
}
__device__ __forceinline__ void ln2_pass(const Args& a, int gw, int NGW, int lane) {
    for (int m = gw; m < TT; m += NGW) {
        float* yr = a.out + (size_t)m * DM;
        f32x4 y[4]; ln_row(yr, a.in[18], a.in[19], lane, y);
#pragma unroll
        for (int j = 0; j < 4; ++j) ((f32x4*)yr + lane)[64 * j] = y[j];
    }
}
__device__ __forceinline__ float gelu_exact(float x) { return 0.5f * x * (1.0f + erff(x * 0.70710678118654752f)); }
__device__ __forceinline__ void conv_pass(const Args& a, int gtid, int NGT) {
    const bf16* UV = (const bf16*)(a.ws + WS_UV); bf16* G = (bf16*)(a.ws + WS_G);
    const float* cw = a.in[15]; const float* cb = a.in[16]; const float* st = a.in[6];
    for (int it = gtid; it < TT * (FF / 8); it += NGT) {
        const int row = it / (FF / 8), c = (it % (FF / 8)) * 8;
        const int uc = ((c >> 7) << 8) + (c & 127);
        const u32x4 u0 = *(const u32x4*)(UV + (size_t)row * NUP + uc), vv = *(const u32x4*)(UV + (size_t)row * NUP + uc + 128);
        float u1[8], u2[8];
        int tpos; const float* s1 = nullptr; const float* s2 = nullptr;
        if (row < TP) tpos = row & (SEQ - 1); else { tpos = row & 3; const int n = (row - TP) >> 2; s2 = st + ((size_t)n * 2 + 0) * FF + c; s1 = st + ((size_t)n * 2 + 1) * FF + c; }
        if (tpos >= 1) { const u32x4 w = *(const u32x4*)(UV + (size_t)(row - 1) * NUP + uc);
#pragma unroll
            for (int k = 0; k < 4; ++k) { u1[2 * k] = bflo(w[k]); u1[2 * k + 1] = bfhi(w[k]); } }
        else {
#pragma unroll
            for (int k = 0; k < 8; ++k) u1[k] = s1 ? s1[k] : 0.f; }
        if (tpos >= 2) { const u32x4 w = *(const u32x4*)(UV + (size_t)(row - 2) * NUP + uc);
#pragma unroll
            for (int k = 0; k < 4; ++k) { u2[2 * k] = bflo(w[k]); u2[2 * k + 1] = bfhi(w[k]); } }
        else if (tpos == 1) {
#pragma unroll
            for (int k = 0; k < 8; ++k) u2[k] = s1 ? s1[k] : 0.f; }
        else {
#pragma unroll
            for (int k = 0; k < 8; ++k) u2[k] = s2 ? s2[k] : 0.f; }
        u32x4 r;
#pragma unroll
        for (int k = 0; k < 4; ++k) {
            const int c0 = c + 2 * k, c1 = c0 + 1;
            const float a0 = cw[c0] * u2[2 * k] + cw[FF + c0] * u1[2 * k] + cw[2 * FF + c0] * bflo(u0[k]) + cb[c0];
            const float a1 = cw[c1] * u2[2 * k + 1] + cw[FF + c1] * u1[2 * k + 1] + cw[2 * FF + c1] * bfhi(u0[k]) + cb[c1];
            r[k] = pk2(gelu_exact(a0) * bflo(vv[k]), gelu_exact(a1) * bfhi(vv[k]));
        }
        *(u32x4*)(G + (size_t)row * FF + c) = r;
    }
}

__global__ void __launch_bounds__(NTHREADS, 2) fwd_kernel(Args args) {
    extern __shared__ __attribute__((aligned(16))) unsigned char lds_raw[];
    LAS unsigned char* lds = (LAS unsigned char*)lds_raw;
    const int tid = threadIdx.x, lane = tid & 63, wave = __builtin_amdgcn_readfirstlane(tid >> 6);
    const int G = gridDim.x, bx = blockIdx.x;
    const int vcu = (G % 8 == 0) ? (bx % 8) * (G / 8) + bx / 8 : bx;
    const int gw = vcu * NWAVES + wave, NGW = G * NWAVES, gtid = vcu * NTHREADS + tid, NGT = G * NTHREADS;
    unsigned char* ws = args.ws;
    const int lo = args.ph_lo, hi = args.ph_hi;
#ifndef PHMASK
#define PHMASK 0xfff
#endif
#define IN(k) (((PHMASK >> (k)) & 1) && lo <= (k) && (k) < hi)
#define SEAM(k) do { if (IN(k) && IN((k) + 1)) { cg::this_grid().sync(); } } while (0)

    if (IN(0)) { p0_prologue(args, lds, gw, NGW, wave, lane); }
    SEAM(0);
    if (IN(1)) {
        pg8::Gemm g{(const pg8::bf16_t*)(ws + WS_XB), (const pg8::bf16_t*)(ws + WS_WIN), TT, NPROJ, DM}; pg8::StaticOrder S; S.init(TT, NPROJ, G, bx);
        pg8::EpiProj E{(pg8::bf16_t*)(ws + WS_PROJ), (const float*)(ws + WS_ROPE), args.out};
        pg8::gemm_phase<pg8::EpiProj, pg8::StaticOrder, true, true>(lds, g, S, E);
    }
    SEAM(1);
    if (IN(2)) {
        for (int i = tid; i < 16 * att::KP / 4; i += NTHREADS) { ((LAS unsigned*)(lds + att::LDS_K + 256 * att::KP))[i] = 0u; ((LAS unsigned*)(lds + att::LDS_V + 256 * att::KP))[i] = 0u; }
        for (int u = vcu; u < 1792; u += G) att::prompt_unit(args, lds, u, tid, wave, lane);
        att::sample_tasks(args, gw, NGW, lane);
        __syncthreads();
    }
    SEAM(2);
    if (IN(3)) { combine_pass(args, gtid, NGT); }
    SEAM(3);
    if (IN(4)) {
        pg8::Gemm g{(const pg8::bf16_t*)(ws + WS_OA), (const pg8::bf16_t*)(ws + WS_WBRA), TT, DM, 512}; pg8::StaticOrder S; S.init(TT, DM, G, bx);
        pg8::EpiGate<0> E{(const pg8::bf16_t*)(ws + WS_PROJ), nullptr, (pg8::bf16_t*)(ws + WS_T1)};
        pg8::gemm_phase<pg8::EpiGate<0>, pg8::StaticOrder, true, true>(lds, g, S, E);
    }
    SEAM(4);
    if (IN(5)) {
        pg8::Gemm g{(const pg8::bf16_t*)(ws + WS_OB), (const pg8::bf16_t*)(ws + WS_WBRB), TT, DM, 256}; pg8::StaticOrder S; S.init(TT, DM, G, bx);
        pg8::EpiGate<1> E{(const pg8::bf16_t*)(ws + WS_PROJ), (const pg8::bf16_t*)(ws + WS_T1), (pg8::bf16_t*)(ws + WS_M)};
        pg8::gemm_phase<pg8::EpiGate<1>, pg8::StaticOrder, true, true>(lds, g, S, E);
    }
    SEAM(5);
    if (IN(6)) {
        pg8::Gemm g{(const pg8::bf16_t*)(ws + WS_M), (const pg8::bf16_t*)(ws + WS_WO), TT, DM, DM}; pg8::StaticOrder S; S.init(TT, DM, G, bx);
        pg8::EpiZ1 E{args.in[0], args.in[1], (float*)(ws + WS_Z1)};
        pg8::gemm_phase<pg8::EpiZ1, pg8::StaticOrder, true, true>(lds, g, S, E);
    }
    SEAM(6);
    if (IN(7)) { ln1_pass(args, gw, NGW, lane); }
    SEAM(7);
    if (IN(8)) {
        pg8::Gemm g{(const pg8::bf16_t*)(ws + WS_HB), (const pg8::bf16_t*)(ws + WS_WUP), TT, NUP, DM}; pg8::StaticOrder S; S.init(TT, NUP, G, bx);
        pg8::EpiUV E{(pg8::bf16_t*)(ws + WS_UV), args.out};
        pg8::gemm_phase<pg8::EpiUV, pg8::StaticOrder, true, true>(lds, g, S, E);
    }
    SEAM(8);
    if (IN(9)) { conv_pass(args, gtid, NGT); }
    SEAM(9);
    if (IN(10)) {
        pg8::Gemm g{(const pg8::bf16_t*)(ws + WS_G), (const pg8::bf16_t*)(ws + WS_WDN), TT, DM, FF}; pg8::StaticOrder S; S.init(TT, DM, G, bx);
        pg8::EpiZ2 E{(const pg8::bf16_t*)(ws + WS_HB), args.out};
        pg8::gemm_phase<pg8::EpiZ2, pg8::StaticOrder, true, true>(lds, g, S, E);
    }
    SEAM(10);
    if (IN(11)) { ln2_pass(args, gw, NGW, lane); }
#undef IN
#undef SEAM
}

#ifndef N_LAUNCH_MODE
#define N_LAUNCH_MODE 1
#endif
extern "C" void kernel_launch(void* const* d_in, const int* in_sizes, int n_in, void* d_out, int out_size, void* d_ws, size_t ws_size, hipStream_t stream) {
    static int grid = 0;
    if (grid == 0) {
        if (n_in != 20 || (size_t)out_size != O_END || ws_size < WS_END) { fprintf(stderr, "kernel_launch: unexpected shapes: n_in %d out %d ws %zu\n", n_in, out_size, ws_size); grid = -1; return; }
        int dev = 0, cus = 0, per_cu = 0;
        if (hipGetDevice(&dev) != hipSuccess || hipDeviceGetAttribute(&cus, hipDeviceAttributeMultiprocessorCount, dev) != hipSuccess) { grid = -1; return; }
        if (hipFuncSetAttribute((const void*)fwd_kernel, hipFuncAttributeMaxDynamicSharedMemorySize, LDS_BYTES) != hipSuccess) { fprintf(stderr, "kernel_launch: hipFuncSetAttribute failed\n"); grid = -1; return; }
        if (hipOccupancyMaxActiveBlocksPerMultiprocessor(&per_cu, (const void*)fwd_kernel, NTHREADS, LDS_BYTES) != hipSuccess || per_cu < 1) { fprintf(stderr, "kernel_launch: occupancy query says %d\n", per_cu); per_cu = 1; }
        (void)hipGetLastError();
        grid = cus;
        if (grid > 256) grid = 256;
    }
    if (grid < 0) return;
    Args a{};
    for (int i = 0; i < 20; ++i) a.in[i] = (const float*)d_in[i];
    a.out = (float*)d_out; a.ws = (unsigned char*)d_ws;
    for (int d = 0; d < 32; ++d) a.inv_freq[d] = pow(10000.0, -(double)d / 32.0);
    if (N_LAUNCH_MODE == 1) {
        a.ph_lo = 0; a.ph_hi = NPHASE; a.coop = 1;
        void* kargs[] = {&a};
        hipError_t e = hipLaunchCooperativeKernel((const void*)fwd_kernel, dim3(grid), dim3(NTHREADS), kargs, LDS_BYTES, stream);
        if (e != hipSuccess) fprintf(stderr, "kernel_launch: cooperative launch failed: %s (grid %d)\n", hipGetErrorString(e), grid);
    } else {
        for (int p = 0; p < NPHASE; ++p) {
            a.ph_lo = p; a.ph_hi = p + 1; a.coop = 0;
            hipLaunchKernelGGL(fwd_kernel, dim3(grid), dim3(NTHREADS), LDS_BYTES, stream, a);
        }
    }
}
```

```cpp
#include <hip/hip_runtime.h>
#include <hip/hip_cooperative_groups.h>
#include <cstdio>
#include <cstdint>
#include <cmath>
namespace cg = cooperative_groups;

constexpr int TP = 16384, TS = 512, TT = TP + TS;
constexpr int DM = 1024, NPROJ = 5120, FF = 2816, NUP = 2 * FF;
constexpr int SEQ = 2048, PAST = 16384;
constexpr float ALPHA = 1.189207115002721f;
constexpr float LN_EPS = 1e-5f;
constexpr float QSCALE = 0.125f * 1.4426950408889634f;
constexpr float LOG2E = 1.4426950408889634f, LN2 = 0.6931471805599453f;
constexpr size_t O_Y = 0;
constexpr size_t O_CA_P = (size_t)TT * DM;
constexpr size_t O_CA_S = O_CA_P + 8 * 128 * 2 * 2 * 64;
constexpr size_t O_CB1_P = O_CA_S + 128 * 4 * 2 * 2 * 64;
constexpr size_t O_CB1_S = O_CB1_P + 8 * 128 * 512;
constexpr size_t O_CB2_P = O_CB1_S + 128 * 4 * 512;
constexpr size_t O_CB2_S = O_CB2_P + 8 * 512 * 512;
constexpr size_t O_CB3_P = O_CB2_S + 128 * 4 * 512;
constexpr size_t O_CB3_S = O_CB3_P + (size_t)8 * 2048 * 512;
constexpr size_t O_SC_P = O_CB3_S + 128 * 4 * 512;
constexpr size_t O_SC_S = O_SC_P + 8 * 2 * FF;
constexpr size_t O_END = O_SC_S + 128 * 2 * FF;
constexpr size_t MiB = 1u << 20;
constexpr size_t WS_CTL = 0, WS_ROPE = 1 * MiB, WS_WIN = 2 * MiB, WS_WBRA = 12 * MiB, WS_WBRB = 13 * MiB, WS_WO = 14 * MiB, WS_WUP = 16 * MiB, WS_WDN = 27 * MiB;
constexpr size_t WS_XB = 34 * MiB, WS_PROJ = 68 * MiB, WS_OA = 234 * MiB, WS_OBG = 252 * MiB, WS_LSE = 277 * MiB, WS_OB = 278 * MiB;
constexpr size_t WS_T1 = 288 * MiB, WS_M = 322 * MiB, WS_Z1 = 356 * MiB, WS_HB = 422 * MiB, WS_UV = 456 * MiB, WS_HALO = 456 * MiB  , WS_G = 638 * MiB, WS_END = 730 * MiB;

namespace pg8 {
#define PG8_LAS __attribute__((address_space(3)))
typedef unsigned short bf16_t;
typedef short bf16x8 __attribute__((ext_vector_type(8)));
typedef float f32x4 __attribute__((ext_vector_type(4)));
typedef unsigned u32x4 __attribute__((ext_vector_type(4)));
constexpr int BM = 256, BK = 64, HALF = 128, HTB = HALF * BK * 2  , STAGE_BYTES = 8 * HTB, NXCD = 8, WGM = 8;

__host__ __device__ __forceinline__ int lds_byte(int r, int c) { const int st = (r >> 4) * 2 + (c >> 5), rr = r & 15, cc = c & 31, ob = rr * 64 + cc * 2; return st * 1024 + (ob ^ (((ob >> 9) & 1) << 5)); }
__host__ __device__ __forceinline__ void stage_rc(int b, int& R, int& C) { const int st = b / 1024, sb = b % 1024, swz = sb ^ (((sb >> 9) & 1) << 5); R = (st >> 1) * 16 + swz / 64; C = (st & 1) * 32 + (swz % 64) / 2; }
__host__ __device__ __forceinline__ int perm32(int rho) { const int n = rho >> 4, i = rho & 15; return 8 * (i >> 2) + 4 * n + (i & 3); }

struct Unit { int pm, pn; };
struct Gemm { const bf16_t* A; const bf16_t* Bt; int M, N, K; };

struct StaticOrder {
    int nM, nN, nwg, G, c;
    __host__ __device__ void init(int M, int N, int G_, int c_) { nM = M / BM; nN = N / BM; nwg = nM * nN; G = G_; c = c_; }
    __host__ __device__ bool next(int i, Unit& u) const {
        const long L = (long)i * G + c; if (L >= nwg) return false;
        int wgid = (int)L; { const int q = nwg / NXCD, r = nwg % NXCD, xcd = wgid % NXCD, off = wgid / NXCD; wgid = (xcd < r ? xcd * (q + 1) : r * (q + 1) + (xcd - r) * q) + off; }
        const int nig = WGM * nN, gid = wgid / nig, fm = gid * WGM, gsz = (nM - fm) < WGM ? (nM - fm) : WGM;
        u.pm = fm + ((wgid % nig) % gsz); u.pn = (wgid % nig) / gsz; return true;
    }
    __device__ __forceinline__ void a_ready(const Unit&) const {}
    __device__ __forceinline__ void done(const Unit&) const {}
};

__device__ __forceinline__ unsigned cvt_pk_bf16(float lo, float hi) { unsigned r; asm volatile("v_cvt_pk_bf16_f32 %0, %1, %2" : "=v"(r) : "v"(lo), "v"(hi)); return r; }
typedef float f32x2 __attribute__((ext_vector_type(2)));
__device__ __forceinline__ f32x2 gelu_pk(f32x2 v) {
    const f32x2 av = __builtin_elementwise_abs(v), d = av * 0.2316418882f + 1.0f;
    f32x2 t; t.x = __builtin_amdgcn_rcpf(d.x); t.y = __builtin_amdgcn_rcpf(d.y);
    f32x2 q = t * 0.5307027145f + (-0.7265760135f); q = q * t + 0.7107068705f; q = q * t + (-0.142248368f); q = q * t + 0.127414796f; q = q * t;
    const f32x2 s = (v * v) * (-0.72134752044f);
    f32x2 e; e.x = __builtin_amdgcn_exp2f(s.x); e.y = __builtin_amdgcn_exp2f(s.y);
    const f32x2 m = v * (q * e), r = v - m;
    f32x2 o; o.x = v.x < 0.f ? m.x : r.x; o.y = v.y < 0.f ? m.y : r.y; return o;
}

typedef unsigned u32x2 __attribute__((ext_vector_type(2)));
__device__ __forceinline__ float bf_lo(unsigned w) { return __uint_as_float(w << 16); }
__device__ __forceinline__ float bf_hi(unsigned w) { return __uint_as_float(w & 0xffff0000u); }
__device__ __forceinline__ float sigmoidf_(float x) { return __builtin_amdgcn_rcpf(1.0f + __builtin_amdgcn_exp2f(-x * 1.4426950408889634f)); }

struct EpiProj {
    static constexpr bool PERM = false, AFTER_DRAIN = false;
    bf16_t* P; const float* rope; float* out;
    __device__ __forceinline__ void operator()(const f32x4 (&acc)[2][2][4][2], const Unit& u, int wr, int wc, int fr, int fq) const {
#pragma unroll
        for (int bj = 0; bj < 2; ++bj) {
            const int hs = 4 * u.pn + 2 * bj + (wc >> 1);
            const int d0 = 16 * (wc & 1) + 4 * fq;
            const bool is_q = (hs < 8) || (hs >= 12 && hs < 24);
            const bool is_k = (hs >= 8 && hs < 10) || (hs >= 24 && hs < 36);
            const bool is_v = (hs >= 10 && hs < 12) || (hs >= 36 && hs < 48);
            const bool do_rope = is_q || is_k;
#pragma unroll
            for (int ai = 0; ai < 2; ++ai)
#pragma unroll
                for (int m = 0; m < 4; ++m) {
                    const int row = u.pm * BM + ai * HALF + wr * 64 + m * 16 + fr;
                    f32x4 v0 = acc[ai][bj][m][0], v1 = acc[ai][bj][m][1];
                    if (do_rope) {
                        const int pidx = row < TP ? (row & (SEQ - 1)) : SEQ + (row & 3);
                        const f32x4* rp = (const f32x4*)(rope + ((size_t)pidx * 32 + d0) * 2);
                        const f32x4 c01 = rp[0], c23 = rp[1];
                        f32x4 o0, o1;
                        o0[0] = v0[0] * c01[0] - v1[0] * c01[1]; o1[0] = v1[0] * c01[0] + v0[0] * c01[1];
                        o0[1] = v0[1] * c01[2] - v1[1] * c01[3]; o1[1] = v1[1] * c01[2] + v0[1] * c01[3];
                        o0[2] = v0[2] * c23[0] - v1[2] * c23[1]; o1[2] = v1[2] * c23[0] + v0[2] * c23[1];
                        o0[3] = v0[3] * c23[2] - v1[3] * c23[3]; o1[3] = v1[3] * c23[2] + v0[3] * c23[3];
                        v0 = o0; v1 = o1;
                    }
                    if (is_k || is_v) {
                        float* dst = nullptr;
                        const int kv = is_v ? 1 : 0;
                        if (hs < 12) {
                            const int kh = (hs - 8) & 1;
                            if (row < TP) { const int b = row >> 11, t = row & (SEQ - 1); if (t >= SEQ - 128) dst = out + O_CA_P + ((((size_t)b * 128 + (t - (SEQ - 128))) * 2 + kv) * 2 + kh) * 64; }
                            else { const int r = row - TP; dst = out + O_CA_S + (((size_t)r * 2 + kv) * 2 + kh) * 64; }
                        } else {
                            const int hb = (hs - 24) % 12, g = hb >> 2, s = hb & 3, lb = 128 << (2 * g);
                            const size_t op = g == 0 ? O_CB1_P : (g == 1 ? O_CB2_P : O_CB3_P), os = g == 0 ? O_CB1_S : (g == 1 ? O_CB2_S : O_CB3_S);
                            if (row < TP) { const int b = row >> 11, t = row & (SEQ - 1); if (t >= SEQ - lb) dst = out + op + ((((size_t)b * lb + (t - (SEQ - lb))) * 2 + kv) * 4 + s) * 64; }
                            else { const int r = row - TP; dst = out + os + (((size_t)r * 2 + kv) * 4 + s) * 64; }
                        }
                        if (dst) { *(f32x4*)(dst + d0) = v0; *(f32x4*)(dst + d0 + 32) = v1; }
                    }
                    if (is_q) { v0 = v0 * QSCALE; v1 = v1 * QSCALE; }
                    bf16_t* pp = P + (size_t)row * NPROJ + hs * 64 + d0;
                    u32x2 w0, w1; w0.x = cvt_pk_bf16(v0[0], v0[1]); w0.y = cvt_pk_bf16(v0[2], v0[3]); w1.x = cvt_pk_bf16(v1[0], v1[1]); w1.y = cvt_pk_bf16(v1[2], v1[3]);
                    *(u32x2*)pp = w0; *(u32x2*)(pp + 32) = w1;
                }
        }
    }
};

template <int SECOND> struct EpiGate {
    static constexpr bool PERM = true, AFTER_DRAIN = false;
    const bf16_t* P; const bf16_t* T1in; bf16_t* O;
    __device__ __forceinline__ void operator()(const f32x4 (&acc)[2][2][4][2], const Unit& u, int wr, int wc, int fr, int fq) const {
        const int row0 = u.pm * BM + wr * 64 + fr, col0 = u.pn * BM + wc * 32 + 8 * fq;
#pragma unroll
        for (int ai = 0; ai < 2; ++ai)
#pragma unroll
            for (int m = 0; m < 4; ++m) {
                const int row = row0 + ai * HALF + m * 16;
#pragma unroll
                for (int bj = 0; bj < 2; ++bj) {
                    const int col = col0 + bj * HALF;
                    const u32x4 gw = *(const u32x4*)(P + (size_t)row * NPROJ + (SECOND ? 4096 : 3072) + col);
                    f32x4 v0 = acc[ai][bj][m][0], v1 = acc[ai][bj][m][1];
                    v0[0] *= sigmoidf_(bf_lo(gw.x)); v0[1] *= sigmoidf_(bf_hi(gw.x)); v0[2] *= sigmoidf_(bf_lo(gw.y)); v0[3] *= sigmoidf_(bf_hi(gw.y));
                    v1[0] *= sigmoidf_(bf_lo(gw.z)); v1[1] *= sigmoidf_(bf_hi(gw.z)); v1[2] *= sigmoidf_(bf_lo(gw.w)); v1[3] *= sigmoidf_(bf_hi(gw.w));
                    if (SECOND) { const u32x4 tw = *(const u32x4*)(T1in + (size_t)row * DM + col);
                        v0[0] += bf_lo(tw.x); v0[1] += bf_hi(tw.x); v0[2] += bf_lo(tw.y); v0[3] += bf_hi(tw.y);
                        v1[0] += bf_lo(tw.z); v1[1] += bf_hi(tw.z); v1[2] += bf_lo(tw.w); v1[3] += bf_hi(tw.w); }
                    u32x4 w; w.x = cvt_pk_bf16(v0[0], v0[1]); w.y = cvt_pk_bf16(v0[2], v0[3]); w.z = cvt_pk_bf16(v1[0], v1[1]); w.w = cvt_pk_bf16(v1[2], v1[3]);
                    *(u32x4*)(O + (size_t)row * DM + col) = w;
                }
                asm volatile("" ::: "memory");
            }
    }
};

struct EpiZ1 {
    static constexpr bool PERM = false, AFTER_DRAIN = false;
    const float* xp; const float* xs; float* Z;
    __device__ __forceinline__ void operator()(const f32x4 (&acc)[2][2][4][2], const Unit& u, int wr, int wc, int fr, int fq) const {
        const int row0 = u.pm * BM + wr * 64 + fr, col0 = u.pn * BM + wc * 32 + 4 * fq;
#pragma unroll
        for (int ai = 0; ai < 2; ++ai)
#pragma unroll
            for (int m = 0; m < 4; ++m) {
                const int row = row0 + ai * HALF + m * 16;
                const float* xr = row < TP ? xp + (size_t)row * DM : xs + (size_t)(row - TP) * DM;
#pragma unroll
                for (int bj = 0; bj < 2; ++bj)
#pragma unroll
                    for (int n = 0; n < 2; ++n) { const int col = col0 + bj * HALF + n * 16;
                        const f32x4 xv = *(const f32x4*)(xr + col);
                        *(f32x4*)(Z + (size_t)row * DM + col) = xv * ALPHA + acc[ai][bj][m][n]; }
            }
    }
};

struct EpiUV {
    static constexpr bool PERM = true, AFTER_DRAIN = false;
    bf16_t* UV; float* out;
    __device__ __forceinline__ void operator()(const f32x4 (&acc)[2][2][4][2], const Unit& u, int wr, int wc, int fr, int fq) const {
        const int row0 = u.pm * BM + wr * 64 + fr, ct0 = wc * 32 + 8 * fq;
#pragma unroll
        for (int ai = 0; ai < 2; ++ai)
#pragma unroll
            for (int m = 0; m < 4; ++m) {
                const int row = row0 + ai * HALF + m * 16;
#pragma unroll
                for (int bj = 0; bj < 2; ++bj) {
                    const f32x4 v0 = acc[ai][bj][m][0], v1 = acc[ai][bj][m][1];
                    u32x4 w; w.x = cvt_pk_bf16(v0[0], v0[1]); w.y = cvt_pk_bf16(v0[2], v0[3]); w.z = cvt_pk_bf16(v1[0], v1[1]); w.w = cvt_pk_bf16(v1[2], v1[3]);
                    *(u32x4*)(UV + (size_t)row * NUP + u.pn * BM + bj * HALF + ct0) = w;
                    if (bj == 0) {
                        float* dst = nullptr; const int ucol = u.pn * HALF + ct0;
                        if (row < TP) { const int b = row >> 11, t = row & (SEQ - 1); if (t >= SEQ - 2) dst = out + O_SC_P + ((size_t)b * 2 + (t - (SEQ - 2))) * FF + ucol; }
                        else { const int r = row - TP, n = r >> 2, qi = r & 3; if (qi >= 2) dst = out + O_SC_S + ((size_t)n * 2 + (qi - 2)) * FF + ucol; }
                        if (dst) { *(f32x4*)dst = v0; *(f32x4*)(dst + 4) = v1; }
                    }
                }
            }
    }
};

template <int CTRL> __device__ __forceinline__ float dpp_mov(float v) { return __builtin_bit_cast(float, __builtin_amdgcn_update_dpp(0, __builtin_bit_cast(int, v), CTRL, 0xf, 0xf, true)); }
template <int CTRL> __device__ __forceinline__ float dpp_upd(float old, float v) { return __builtin_bit_cast(float, __builtin_amdgcn_update_dpp(__builtin_bit_cast(int, old), __builtin_bit_cast(int, v), CTRL, 0xf, 0xf, false)); }
constexpr unsigned HALO_TAG = 0x5eed0001u;
struct ConvOrder {
    int x, cl, nx;
    __host__ __device__ void init(int G_, int c_) { x = c_ & 7; cl = c_ >> 3; nx = G_ >> 3; }
    __host__ __device__ bool next(int i, Unit& u) const {
        const int Lx = i * nx + cl;
        if (Lx < 176) { u.pm = 8 * x + (Lx & 7); u.pn = Lx >> 3; return true; }
        const int sidx = (Lx - 176) * 8 + x; if (sidx >= 44) return false;
        u.pm = 64 + (sidx & 1); u.pn = sidx >> 1; return true;
    }
    __device__ __forceinline__ void a_ready(const Unit&) const {}
    __device__ __forceinline__ void done(const Unit&) const {}
};
struct EpiConv {
    static constexpr bool PERM = true, AFTER_DRAIN = false;
    bf16_t* Gout; float* out; const float* cw; const float* cb; const float* st; unsigned long long* halo; PG8_LAS float* xbuf;
    __device__ __forceinline__ void finish(const f32x4 (&cur)[2], const f32x4 (&t1)[2], const f32x4 (&t2)[2], const f32x4 (&vv)[2], const f32x4 (&w0)[2], const f32x4 (&w1)[2], const f32x4 (&w2)[2], const f32x4 (&bb)[2], bf16_t* dst) const {
        u32x4 w;
#pragma unroll
        for (int n = 0; n < 2; ++n) {
            const f32x4 a = w0[n] * t2[n] + w1[n] * t1[n] + w2[n] * cur[n] + bb[n];
            const f32x2 g0 = gelu_pk((f32x2){a[0], a[1]}), g1 = gelu_pk((f32x2){a[2], a[3]});
            const unsigned lo = cvt_pk_bf16(g0.x * vv[n][0], g0.y * vv[n][1]), hi = cvt_pk_bf16(g1.x * vv[n][2], g1.y * vv[n][3]);
            if (n == 0) { w.x = lo; w.y = hi; } else { w.z = lo; w.w = hi; }
        }
        *(u32x4*)dst = w;
    }
    __device__ __forceinline__ void operator()(const f32x4 (&acc)[2][2][4][2], const Unit& u, int wr, int wc, int fr, int fq) const {
        const int col = u.pn * HALF + wc * 32 + 8 * fq;
        f32x4 w0[2], w1[2], w2[2], bb[2];
#pragma unroll
        for (int n = 0; n < 2; ++n) { w0[n] = *(const f32x4*)(cw + col + 4 * n); w1[n] = *(const f32x4*)(cw + FF + col + 4 * n); w2[n] = *(const f32x4*)(cw + 2 * FF + col + 4 * n); bb[n] = *(const f32x4*)(cb + col + 4 * n); }
        if (u.pm >= 64) {
#pragma unroll
            for (int ai = 0; ai < 2; ++ai)
#pragma unroll
                for (int m = 0; m < 4; ++m) {
                    const int row = u.pm * BM + ai * HALF + wr * 64 + m * 16 + fr, r = row - TP, nb = r >> 2, qi = r & 3;
                    f32x4 cur[2], vv[2], t1[2], t2[2];
#pragma unroll
                    for (int n = 0; n < 2; ++n) {
                        cur[n] = acc[ai][0][m][n]; vv[n] = acc[ai][1][m][n];
                        const f32x4 s0 = *(const f32x4*)(st + ((size_t)nb * 2 + 0) * FF + col + 4 * n), s1 = *(const f32x4*)(st + ((size_t)nb * 2 + 1) * FF + col + 4 * n);
#pragma unroll
                        for (int e = 0; e < 4; ++e) { const float a1 = dpp_mov<0x111>(cur[n][e]), a2 = dpp_mov<0x112>(cur[n][e]);
                            t1[n][e] = qi >= 1 ? a1 : s1[e]; t2[n][e] = qi >= 2 ? a2 : (qi == 1 ? s1[e] : s0[e]); }
                    }
                    if (qi >= 2) { float* dst = out + O_SC_S + ((size_t)nb * 2 + (qi - 2)) * FF + col; *(f32x4*)dst = cur[0]; *(f32x4*)(dst + 4) = cur[1]; }
                    finish(cur, t1, t2, vv, w0, w1, w2, bb, Gout + (size_t)row * FF + col);
                }
            return;
        }
        const int seqtile = u.pm & 7;
        if (wr == 1 && fr >= 14) {
            if (seqtile != 7) {
                unsigned long long* hp = halo + (((size_t)(u.pm * 22 + u.pn) * 4 + wc) * 8 + (fr & 1) * 4 + fq) * 8;
#pragma unroll
                for (int n = 0; n < 2; ++n)
#pragma unroll
                    for (int e = 0; e < 4; ++e) __hip_atomic_store(hp + 4 * n + e, ((unsigned long long)HALO_TAG << 32) | (unsigned long long)__float_as_uint(acc[1][0][3][n][e]), __ATOMIC_RELAXED, __HIP_MEMORY_SCOPE_AGENT);
            } else {
                float* dst = out + O_SC_P + ((size_t)(u.pm >> 3) * 2 + (fr - 14)) * FF + col; *(f32x4*)dst = acc[1][0][3][0]; *(f32x4*)(dst + 4) = acc[1][0][3][1];
            }
        }
        if (fr >= 14) {
#pragma unroll
            for (int ai = 0; ai < 2; ++ai) { PG8_LAS float* xb = xbuf + ((((wr * 4 + wc) * 2 + ai) * 2 + (fr & 1)) * 4 + fq) * 8; *(PG8_LAS f32x4*)xb = acc[ai][0][3][0]; *(PG8_LAS f32x4*)(xb + 4) = acc[ai][0][3][1]; }
        }
        asm volatile("s_waitcnt lgkmcnt(0)" ::: "memory"); __builtin_amdgcn_s_barrier(); asm volatile("" ::: "memory");
#pragma unroll
        for (int ai = 0; ai < 2; ++ai) {
            f32x4 prev[2];
            const int blk = 2 * ai + wr;
            if (blk == 0) {
                prev[0] = (f32x4){0.f, 0.f, 0.f, 0.f}; prev[1] = prev[0];
                if (seqtile != 0) {
                    const unsigned long long* hp = halo + (((size_t)((u.pm - 1) * 22 + u.pn) * 4 + wc) * 8 + (fr & 1) * 4 + fq) * 8;
                    unsigned long long gv[8];
                    for (unsigned spins = 0;; ++spins) {
                        bool ok = true;
#pragma unroll
                        for (int k = 0; k < 8; ++k) { gv[k] = __hip_atomic_load(hp + k, __ATOMIC_RELAXED, __HIP_MEMORY_SCOPE_AGENT); ok &= (unsigned)(gv[k] >> 32) == HALO_TAG; }
                        if (__all(ok) || spins > (1u << 17)) break;
                        __builtin_amdgcn_s_sleep(2);
                    }
#pragma unroll
                    for (int k = 0; k < 8; ++k) prev[k >> 2][k & 3] = __uint_as_float((unsigned)gv[k]);
                }
            } else {
                const int pw = (blk - 1) & 1, pa = (blk - 1) >> 1;
                const PG8_LAS float* xb = xbuf + ((((pw * 4 + wc) * 2 + pa) * 2 + (fr & 1)) * 4 + fq) * 8;
                prev[0] = *(const PG8_LAS f32x4*)xb; prev[1] = *(const PG8_LAS f32x4*)(xb + 4);
            }
#pragma unroll
            for (int m = 0; m < 4; ++m) {
                const int row = u.pm * BM + ai * HALF + wr * 64 + m * 16 + fr;
                f32x4 cur[2], vv[2], t1[2], t2[2];
#pragma unroll
                for (int n = 0; n < 2; ++n) {
                    cur[n] = acc[ai][0][m][n]; vv[n] = acc[ai][1][m][n];
#pragma unroll
                    for (int e = 0; e < 4; ++e) { const float p1 = dpp_mov<0x121>(prev[n][e]), p2 = dpp_mov<0x122>(prev[n][e]);
                        t1[n][e] = dpp_upd<0x111>(p1, cur[n][e]); t2[n][e] = dpp_upd<0x112>(p2, cur[n][e]); }
                }
                finish(cur, t1, t2, vv, w0, w1, w2, bb, Gout + (size_t)row * FF + col);
                prev[0] = cur[0]; prev[1] = cur[1];
            }
        }
    }
};

struct EpiZ2 {
    static constexpr bool PERM = false, AFTER_DRAIN = false;
    const bf16_t* HB; float* Y;
    __device__ __forceinline__ void operator()(const f32x4 (&acc)[2][2][4][2], const Unit& u, int wr, int wc, int fr, int fq) const {
        const int row0 = u.pm * BM + wr * 64 + fr, col0 = u.pn * BM + wc * 32 + 4 * fq;
#pragma unroll
        for (int ai = 0; ai < 2; ++ai)
#pragma unroll
            for (int m = 0; m < 4; ++m) {
                const int row = row0 + ai * HALF + m * 16;
#pragma unroll
                for (int bj = 0; bj < 2; ++bj)
#pragma unroll
                    for (int n = 0; n < 2; ++n) { const int col = col0 + bj * HALF + n * 16;
                        const u32x2 hw = *(const u32x2*)(HB + (size_t)row * DM + col);
                        f32x4 hv; hv[0] = bf_lo(hw.x); hv[1] = bf_hi(hw.x); hv[2] = bf_lo(hw.y); hv[3] = bf_hi(hw.y);
                        *(f32x4*)(Y + (size_t)row * DM + col) = hv * ALPHA + acc[ai][bj][m][n]; }
            }
    }
};

template <class Epi, class Sched, bool ALIGN_EPI = false, bool SP2 = false>
__device__ __forceinline__ void gemm_phase(PG8_LAS unsigned char* lds, const Gemm g, const Sched& S, const Epi& E) {
    const int tid = threadIdx.x, wid = __builtin_amdgcn_readfirstlane(tid >> 6), lane = tid & 63, wr = wid >> 2, wc = wid & 3, fr = lane & 15, fq = lane >> 4;
    int K = g.K; asm volatile("" : "+s"(K));
    const int nt = K / BK;
    unsigned voffA[2], voffB[2];
#pragma unroll
    for (int i = 0; i < 2; ++i) { int R, C; stage_rc(tid * 16 + i * 8192, R, C); const int Rb = Epi::PERM ? ((R & ~31) + perm32(R & 31)) : R;
        voffA[i] = (unsigned)(R * K + C) * 2u; voffB[i] = (unsigned)(Rb * K + C) * 2u; }
    const size_t kstep = (size_t)(BK * 2);
    const size_t hstep = (size_t)HALF * K * 2;
    const size_t tstep = 2 * hstep;
    const unsigned ldsw = (unsigned)wid * 1024u;
    const int aoff = lds_byte(wr * 64 + fr, fq * 8), boff = lds_byte(wc * 32 + fr, fq * 8);
#define PG8_SA(b, h) (((b) * 2 + (h)) * HTB)
#define PG8_SB(b, h) ((4 + (b) * 2 + (h)) * HTB)
#define PG8_STAGE(bufoff, gbase, voff) do { _Pragma("unroll") for (int _i = 0; _i < 2; ++_i) \
        __builtin_amdgcn_global_load_lds((const unsigned*)((const char*)(gbase) + (voff)[_i]), (PG8_LAS unsigned*)(lds + (bufoff) + ldsw + _i * 8192), 16, 0, 0); } while (0)
#define PG8_LDA(dst, b, h) do { _Pragma("unroll") for (int m = 0; m < 4; ++m) _Pragma("unroll") for (int k = 0; k < 2; ++k) dst[m][k] = *(const PG8_LAS bf16x8*)(lds + PG8_SA(b, h) + aoff + m * 2048 + k * 1024); } while (0)
#define PG8_LDB(dst, b, h) do { _Pragma("unroll") for (int n = 0; n < 2; ++n) _Pragma("unroll") for (int k = 0; k < 2; ++k) dst[n][k] = *(const PG8_LAS bf16x8*)(lds + PG8_SB(b, h) + boff + n * 2048 + k * 1024); } while (0)
#define PG8_MMA(ai, bj, At, Bt) do { __builtin_amdgcn_s_setprio(1); _Pragma("unroll") for (int m = 0; m < 4; ++m) _Pragma("unroll") for (int n = 0; n < 2; ++n) _Pragma("unroll") for (int k = 0; k < 2; ++k) \
        acc[ai][bj][m][n] = __builtin_amdgcn_mfma_f32_16x16x32_bf16(Bt[n][k], At[m][k], acc[ai][bj][m][n], 0, 0, 0); __builtin_amdgcn_s_setprio(0); } while (0)
#define PG8_WAIT_V(n) asm volatile("s_waitcnt vmcnt(" #n ")" ::: "memory")
#define PG8_WAIT_L(n) asm volatile("s_waitcnt lgkmcnt(" #n ")" ::: "memory")
#define PG8_BAR __builtin_amdgcn_s_barrier()
#define PG8_SCHED __builtin_amdgcn_sched_barrier(0)
    Unit cur, nxt; int ui = 0;
    if (!S.next(0, cur)) return;
    f32x4 acc[2][2][4][2];
#pragma unroll
    for (int a = 0; a < 2; ++a)
#pragma unroll
        for (int b = 0; b < 2; ++b)
#pragma unroll
            for (int m = 0; m < 4; ++m)
#pragma unroll
                for (int n = 0; n < 2; ++n) acc[a][b][m][n] = (f32x4){0.f, 0.f, 0.f, 0.f};
    bf16x8 At[4][2], B0[2][2], B1[2][2];
    const char* cA = (const char*)g.A + (size_t)cur.pm * tstep; const char* cB = (const char*)g.Bt + (size_t)cur.pn * tstep;
    S.a_ready(cur);
    if constexpr (SP2) {
        PG8_STAGE(PG8_SB(0, 0), cB, voffB); PG8_STAGE(PG8_SB(0, 1), cB + hstep, voffB); PG8_STAGE(PG8_SA(0, 0), cA, voffA); PG8_STAGE(PG8_SA(0, 1), cA + hstep, voffA);
        if (wr == 1) PG8_BAR;
        PG8_WAIT_V(2); PG8_BAR;
        PG8_STAGE(PG8_SB(1, 0), cB + kstep, voffB); PG8_STAGE(PG8_SA(1, 0), cA + kstep, voffA); PG8_STAGE(PG8_SB(1, 1), cB + hstep + kstep, voffB);
        PG8_WAIT_V(6); PG8_BAR;
    } else {
        PG8_STAGE(PG8_SB(0, 0), cB, voffB); PG8_STAGE(PG8_SA(0, 0), cA, voffA); PG8_STAGE(PG8_SB(0, 1), cB + hstep, voffB); PG8_STAGE(PG8_SA(0, 1), cA + hstep, voffA);
        if (wr == 1) PG8_BAR;
        PG8_WAIT_V(4); PG8_BAR;
        PG8_STAGE(PG8_SB(1, 0), cB + kstep, voffB); PG8_STAGE(PG8_SA(1, 0), cA + kstep, voffA); PG8_STAGE(PG8_SB(1, 1), cB + hstep + kstep, voffB);
        PG8_WAIT_V(6); PG8_BAR;
    }
    for (;;) {
        const bool has_next = S.next(ui + 1, nxt);
        const char* nA = has_next ? (const char*)g.A + (size_t)nxt.pm * tstep : cA; const char* nB = has_next ? (const char*)g.Bt + (size_t)nxt.pn * tstep : cB;
        for (int t = 0; t < nt; t += 2) {
            const bool last = (t == nt - 2);
            const char* a1 = cA + (size_t)(t + 1) * kstep;
            const char* a2 = last ? nA : cA + (size_t)(t + 2) * kstep; const char* b2 = last ? nB : cB + (size_t)(t + 2) * kstep;
            const char* a3 = a2 + kstep; const char* b3 = b2 + kstep;
            if (last && has_next) S.a_ready(nxt);
            if constexpr (SP2) {
            PG8_LDB(B0, 0, 0); PG8_LDB(B1, 0, 1); PG8_SCHED; PG8_LDA(At, 0, 0); PG8_STAGE(PG8_SA(1, 1), a1 + hstep, voffA);
            PG8_WAIT_V(8); PG8_WAIT_L(0); PG8_BAR; PG8_MMA(0, 0, At, B0); PG8_MMA(0, 1, At, B1); PG8_BAR; PG8_SCHED;
            PG8_LDA(At, 0, 1); PG8_STAGE(PG8_SB(0, 0), b2, voffB); PG8_STAGE(PG8_SB(0, 1), b2 + hstep, voffB); PG8_STAGE(PG8_SA(0, 0), a2, voffA);
            PG8_WAIT_V(8); PG8_WAIT_L(0); PG8_BAR; PG8_MMA(1, 0, At, B0); PG8_MMA(1, 1, At, B1); PG8_BAR; PG8_SCHED;
            PG8_LDB(B0, 1, 0); PG8_LDB(B1, 1, 1); PG8_SCHED; PG8_LDA(At, 1, 0); PG8_STAGE(PG8_SA(0, 1), a2 + hstep, voffA);
            PG8_WAIT_V(8); PG8_WAIT_L(0); PG8_BAR; PG8_MMA(0, 0, At, B0); PG8_MMA(0, 1, At, B1); PG8_BAR; PG8_SCHED;
            PG8_LDA(At, 1, 1); PG8_STAGE(PG8_SB(1, 0), b3, voffB); PG8_STAGE(PG8_SB(1, 1), b3 + hstep, voffB); PG8_STAGE(PG8_SA(1, 0), a3, voffA);
            PG8_WAIT_V(8); PG8_WAIT_L(0); PG8_BAR; PG8_MMA(1, 0, At, B0); PG8_MMA(1, 1, At, B1); PG8_BAR; PG8_SCHED;
            } else {
            PG8_LDB(B0, 0, 0); PG8_SCHED; PG8_LDA(At, 0, 0); PG8_STAGE(PG8_SA(1, 1), a1 + hstep, voffA);
            PG8_WAIT_L(8); PG8_BAR; PG8_WAIT_L(0); PG8_MMA(0, 0, At, B0); PG8_BAR; PG8_SCHED;
            PG8_LDB(B1, 0, 1); PG8_STAGE(PG8_SB(0, 0), b2, voffB);
            PG8_BAR; PG8_WAIT_L(0); PG8_MMA(0, 1, At, B1); PG8_BAR;
            PG8_LDA(At, 0, 1); PG8_STAGE(PG8_SA(0, 0), a2, voffA);
            PG8_BAR; PG8_WAIT_L(0); PG8_MMA(1, 0, At, B0); PG8_BAR; PG8_SCHED;
            PG8_STAGE(PG8_SB(0, 1), b2 + hstep, voffB);
            PG8_WAIT_V(6); PG8_BAR; PG8_MMA(1, 1, At, B1); PG8_BAR;
            PG8_LDB(B0, 1, 0); PG8_SCHED; PG8_LDA(At, 1, 0); PG8_STAGE(PG8_SA(0, 1), a2 + hstep, voffA);
            PG8_WAIT_L(8); PG8_BAR; PG8_WAIT_L(0); PG8_MMA(0, 0, At, B0); PG8_BAR; PG8_SCHED;
            PG8_LDB(B1, 1, 1); PG8_STAGE(PG8_SB(1, 0), b3, voffB);
            PG8_BAR; PG8_WAIT_L(0); PG8_MMA(0, 1, At, B1); PG8_BAR;
            PG8_LDA(At, 1, 1); PG8_STAGE(PG8_SA(1, 0), a3, voffA);
            PG8_BAR; PG8_WAIT_L(0); PG8_MMA(1, 0, At, B0); PG8_BAR; PG8_SCHED;
            PG8_STAGE(PG8_SB(1, 1), b3 + hstep, voffB);
            PG8_WAIT_V(6); PG8_BAR; PG8_MMA(1, 1, At, B1); PG8_BAR;
            }
        }
        if constexpr (ALIGN_EPI) { if (wr == 0) PG8_BAR; }
        if constexpr (!Epi::AFTER_DRAIN) { E(acc, cur, wr, wc, fr, fq); S.done(cur); }
        if (!has_next) break;
#pragma unroll
        for (int a = 0; a < 2; ++a)
#pragma unroll
            for (int b = 0; b < 2; ++b)
#pragma unroll
                for (int m = 0; m < 4; ++m)
#pragma unroll
                    for (int n = 0; n < 2; ++n) acc[a][b][m][n] = (f32x4){0.f, 0.f, 0.f, 0.f};
        cur = nxt; cA = nA; cB = nB; ++ui;
        if constexpr (ALIGN_EPI) { if (wr == 1) PG8_BAR; }
    }
    PG8_WAIT_V(0);
    if constexpr (!ALIGN_EPI) { if (wr == 0) PG8_BAR; }
    PG8_BAR;
    if constexpr (Epi::AFTER_DRAIN) { E.fused(acc, cur, wr, wc, fr, fq, lds, wid, lane); S.done(cur); }
#undef PG8_SA
#undef PG8_SB
#undef PG8_STAGE
#undef PG8_LDA
#undef PG8_LDB
#undef PG8_MMA
#undef PG8_WAIT_V
#undef PG8_WAIT_L
#undef PG8_BAR
#undef PG8_SCHED
}
}

#define LAS __attribute__((address_space(3)))
typedef unsigned short bf16;
typedef float f32x4 __attribute__((ext_vector_type(4)));
typedef short bf16x8 __attribute__((ext_vector_type(8)));
typedef short s16x4 __attribute__((ext_vector_type(4)));
typedef unsigned u32x4 __attribute__((ext_vector_type(4)));
typedef unsigned u32x2 __attribute__((ext_vector_type(2)));
constexpr int NWAVES = 8, NTHREADS = 512;
constexpr int RING_BYTES = 131072, LDS_BYTES = 147456;
constexpr int NPHASE = 12;

__device__ __forceinline__ unsigned f2bf(float f) { unsigned u = __builtin_bit_cast(unsigned, f); return (u + 0x7fffu + ((u >> 16) & 1u)) >> 16; }
__device__ __forceinline__ unsigned pk2(float lo, float hi) { return f2bf(lo) | (f2bf(hi) << 16); }
__device__ __forceinline__ float bflo(unsigned w) { return __uint_as_float(w << 16); }
__device__ __forceinline__ float bfhi(unsigned w) { return __uint_as_float(w & 0xffff0000u); }
__device__ __forceinline__ float wave_sum(float v) {
#pragma unroll
    for (int o = 1; o < 64; o <<= 1) v += __shfl_xor(v, o);
    return v;
}
template <int CTRL> __device__ __forceinline__ float dppf(float v) { return __builtin_bit_cast(float, __builtin_amdgcn_update_dpp(0, __builtin_bit_cast(int, v), CTRL, 0xf, 0xf, true)); }
__device__ __forceinline__ float row16_sum(float v) {
    v += dppf<0xB1>(v);
    v += dppf<0x4E>(v);
    v += dppf<0x141>(v);
    v += dppf<0x140>(v);
    return v;
}

struct Args { const float* in[20]; float* out; unsigned char* ws; double inv_freq[32]; int ph_lo, ph_hi, coop, pad; };

template <int MAP> __device__ __forceinline__ int rowmap(int n) {
    if (MAP == 1) { const int blk = n >> 6, o = n & 63, nn = o >> 5, half = (o >> 4) & 1, q = o & 15; return (blk << 6) + 32 * half + 16 * nn + q; }
    if (MAP == 2) { return n < FF ? ((n >> 7) << 8) + (n & 127) : (((n - FF) >> 7) << 8) + 128 + ((n - FF) & 127); }
    return n;
}
template <int MAP> __device__ __forceinline__ void p0_transpose_item(const float* W, int K, int N, bf16* WT, LAS float* scr, int item, int lane) {
    const int nblk = N / 32, kb = item / nblk, nb = item % nblk, k0 = 64 * kb, n0 = 32 * nb;
#pragma unroll 8
    for (int i = 0; i < 32; ++i) { const int kk = 2 * i + (lane >> 5); scr[kk * 33 + (lane & 31)] = W[(size_t)(k0 + kk) * N + n0 + (lane & 31)]; }
    asm volatile("s_waitcnt lgkmcnt(0)" ::: "memory");
    const int c = lane & 7;
#pragma unroll
    for (int j = 0; j < 4; ++j) { const int n = (lane >> 3) + 8 * j; const LAS float* s = scr + (8 * c) * 33 + n;
        u32x4 o; o.x = pk2(s[0 * 33], s[1 * 33]); o.y = pk2(s[2 * 33], s[3 * 33]); o.z = pk2(s[4 * 33], s[5 * 33]); o.w = pk2(s[6 * 33], s[7 * 33]);
        *(u32x4*)(WT + (size_t)rowmap<MAP>(n0 + n) * K + k0 + 8 * c) = o; }
    asm volatile("s_waitcnt lgkmcnt(0)" ::: "memory");
}
__device__ __forceinline__ void p0_prologue(const Args& a, LAS unsigned char* lds, int gw, int NGW, int wave, int lane) {
    unsigned char* ws = a.ws;
    LAS float* scr = (LAS float*)(lds + wave * 16384);
    constexpr int I_IN = (DM / 64) * (NPROJ / 32), I_BA = (512 / 64) * (DM / 32), I_BB = (256 / 64) * (DM / 32), I_O = (DM / 64) * (DM / 32), I_UP = (DM / 64) * (NUP / 32), I_DN = (FF / 64) * (DM / 32);
    constexpr int NITEMS = I_IN + I_BA + I_BB + I_O + I_UP + I_DN;
    for (int it = gw; it < NITEMS; it += NGW) {
        int r = it;
        if (r < I_IN) { p0_transpose_item<1>(a.in[7], DM, NPROJ, (bf16*)(ws + WS_WIN), scr, r, lane); continue; } r -= I_IN;
        if (r < I_BA) { p0_transpose_item<0>(a.in[9], 512, DM, (bf16*)(ws + WS_WBRA), scr, r, lane); continue; } r -= I_BA;
        if (r < I_BB) { p0_transpose_item<0>(a.in[10], 256, DM, (bf16*)(ws + WS_WBRB), scr, r, lane); continue; } r -= I_BB;
        if (r < I_O) { p0_transpose_item<0>(a.in[11], DM, DM, (bf16*)(ws + WS_WO), scr, r, lane); continue; } r -= I_O;
        if (r < I_UP) { p0_transpose_item<2>(a.in[14], DM, NUP, (bf16*)(ws + WS_WUP), scr, r, lane); continue; } r -= I_UP;
        p0_transpose_item<0>(a.in[17], FF, DM, (bf16*)(ws + WS_WDN), scr, r, lane);
    }
    bf16* XB = (bf16*)(ws + WS_XB);
    for (int m = gw; m < TT; m += NGW) {
        const float* xr = m < TP ? a.in[0] + (size_t)m * DM : a.in[1] + (size_t)(m - TP) * DM;
        const f32x4* x4 = (const f32x4*)xr + lane; unsigned long long* o8 = (unsigned long long*)(XB + (size_t)m * DM) + lane;
#pragma unroll
        for (int j = 0; j < 4; ++j) { const f32x4 v = x4[64 * j]; o8[64 * j] = (unsigned long long)pk2(v[0], v[1]) | ((unsigned long long)pk2(v[2], v[3]) << 32); }
    }
    { unsigned long long* hz = (unsigned long long*)(ws + WS_HALO); for (int i = gw * 64 + lane; i < 64 * 22 * 256; i += NGW * 64) hz[i] = 0ull; }
    float* rope = (float*)(ws + WS_ROPE);
    for (int e = gw * 64 + lane; e < 2052 * 32; e += NGW * 64) {
        const int p = e >> 5, d = e & 31; const double pos = (double)(p < SEQ ? p : PAST + (p - SEQ));
        const double ang = pos * a.inv_freq[d];
        const double k = rint(ang * 0.15915494309189535);
        double r = fma(-k, 6.283185307179586, ang); r = fma(-k, 2.4492935982947064e-16, r);
        rope[2 * e] = (float)cos(r); rope[2 * e + 1] = (float)sin(r);
    }
}

namespace att {
constexpr int KP = 144, NROW = 272;
constexpr int LDS_K = 0, LDS_V = NROW * KP, LDS_END = 2 * NROW * KP;
static_assert(LDS_END <= RING_BYTES, "attention LDS");
__device__ __forceinline__ void stage_kv(const bf16* Kg, const bf16* Vg, long rstride, bool lowvalid, LAS unsigned char* lds, int tid) {
    const int ch = tid & 7;
#pragma unroll
    for (int it = 0; it < 4; ++it) {
        const int j = (tid >> 3) + 64 * it; const bool ok = lowvalid || j >= 128;
        u32x4 kv = (u32x4){0u, 0u, 0u, 0u}, vv = (u32x4){0u, 0u, 0u, 0u};
        if (ok) { kv = *(const u32x4*)(Kg + (long)j * rstride + ch * 8); vv = *(const u32x4*)(Vg + (long)j * rstride + ch * 8); }
        *(LAS u32x4*)(lds + LDS_K + j * KP + ch * 16) = kv; *(LAS u32x4*)(lds + LDS_V + j * KP + ch * 16) = vv;
    }
}
__device__ __forceinline__ void wave_attend(const LAS unsigned char* lds, int kb0, int ibase, int jmin, const bf16x8 (&qf)[2], float sink2, bool has_sink, f32x4 (&o)[4], float& mrow, float& lrow, int lane) {
    const int g = lane >> 4, ql = lane & 15;
    f32x4 st[5][2];
    const LAS unsigned char* kbase = lds + LDS_K + (kb0 + 8 * (ql >> 2) + (ql & 3)) * KP + 16 * g;
#pragma unroll
    for (int s = 0; s < 5; ++s)
#pragma unroll
        for (int t = 0; t < 2; ++t) {
            f32x4 acc = (f32x4){0.f, 0.f, 0.f, 0.f};
#pragma unroll
            for (int ks = 0; ks < 2; ++ks) { const bf16x8 kf = *(const LAS bf16x8*)(kbase + (32 * s + 4 * t) * KP + 64 * ks);
                acc = __builtin_amdgcn_mfma_f32_16x16x32_bf16(kf, qf[ks], acc, 0, 0, 0); }
            st[s][t] = acc;
        }
    float mx = -1e30f;
#pragma unroll
    for (int s = 0; s < 5; ++s)
#pragma unroll
        for (int t = 0; t < 2; ++t)
#pragma unroll
            for (int r = 0; r < 4; ++r) { const int j = kb0 + 32 * s + 8 * g + 4 * t + r, rel = j - (ibase + ql);
                const bool ok = rel >= 1 && rel <= 128 && j >= jmin; const float x = ok ? st[s][t][r] : -1e30f; st[s][t][r] = x; mx = fmaxf(mx, x); }
    mx = fmaxf(mx, __shfl_xor(mx, 16)); mx = fmaxf(mx, __shfl_xor(mx, 32));
    if (has_sink) mx = fmaxf(mx, sink2);
    float sum = 0.f; bf16x8 pf[5];
#pragma unroll
    for (int s = 0; s < 5; ++s) {
        float p[8];
#pragma unroll
        for (int t = 0; t < 2; ++t)
#pragma unroll
            for (int r = 0; r < 4; ++r) { p[4 * t + r] = __builtin_amdgcn_exp2f(st[s][t][r] - mx); sum += p[4 * t + r]; }
        u32x4 w; w.x = pk2(p[0], p[1]); w.y = pk2(p[2], p[3]); w.z = pk2(p[4], p[5]); w.w = pk2(p[6], p[7]);
        pf[s] = __builtin_bit_cast(bf16x8, w);
    }
    sum += __shfl_xor(sum, 16); sum += __shfl_xor(sum, 32);
    const float den = has_sink ? sum + __builtin_amdgcn_exp2f(sink2 - mx) : sum;
    const LAS unsigned char* vbase = lds + LDS_V + (kb0 + 8 * g + (ql >> 2)) * KP + 8 * (lane & 3);
#pragma unroll
    for (int c = 0; c < 4; ++c) {
        f32x4 acc = (f32x4){0.f, 0.f, 0.f, 0.f};
#pragma unroll
        for (int s = 0; s < 5; ++s) {
            const s16x4 lo = __builtin_bit_cast(s16x4, __builtin_amdgcn_ds_read_tr16_b64_v4i16((LAS s16x4*)(vbase + (32 * s) * KP + 32 * c)));
            const s16x4 hi = __builtin_bit_cast(s16x4, __builtin_amdgcn_ds_read_tr16_b64_v4i16((LAS s16x4*)(vbase + (32 * s + 4) * KP + 32 * c)));
            const bf16x8 vf = (bf16x8){lo[0], lo[1], lo[2], lo[3], hi[0], hi[1], hi[2], hi[3]};
            acc = __builtin_amdgcn_mfma_f32_16x16x32_bf16(vf, pf[s], acc, 0, 0, 0);
        }
        const float inv = 1.0f / den;
        o[c] = acc * inv;
    }
    mrow = mx; lrow = sum;
}

__device__ __forceinline__ void prompt_unit(const Args& a, LAS unsigned char* lds, int uidx, int tid, int wave, int lane) {
    unsigned char* ws = a.ws;
    const bf16* P = (const bf16*)(ws + WS_PROJ);
    int b, blk, dil, nq, qcol, kcol, vcol, grp = 0, slot = 0; bool isA;
    if (uidx < 256) { isA = true; b = uidx >> 5; blk = (uidx >> 1) & 15; const int kh = uidx & 1; dil = 1; nq = 4; qcol = kh * 256; kcol = 512 + kh * 64; vcol = 640 + kh * 64; }
    else { const int v = uidx - 256; isA = false; b = v / 192; const int rem = v % 192, hb = rem >> 4; blk = rem & 15; grp = hb >> 2; slot = hb & 3; dil = 1 << (2 * grp); nq = 1;
        qcol = 768 + hb * 64; kcol = 1536 + hb * 64; vcol = 2304 + hb * 64; }
    const int nbr = 16 / dil;
    const int rho = blk / nbr, beta = blk % nbr;
    const long tok0 = (long)b * SEQ + rho + (long)dil * 128 * (beta - 1);
    const long rstride = (long)dil * NPROJ;
    __syncthreads();
    stage_kv(P + tok0 * NPROJ + kcol, P + tok0 * NPROJ + vcol, rstride, beta > 0, lds, tid);
    __syncthreads();
    const int g = lane >> 4, ql = lane & 15;
    const long qtok = tok0 + (long)dil * (128 + 16 * wave + ql);
    const float* sink = a.in[8];
    for (int h = 0; h < nq; ++h) {
        const bf16* qp = P + qtok * NPROJ + qcol + h * 64 + 8 * g;
        bf16x8 qf[2]; qf[0] = *(const bf16x8*)qp; qf[1] = *(const bf16x8*)(qp + 32);
        f32x4 o[4]; float mrow, lrow;
        const float sk = isA ? sink[(qcol >> 6) + h] * LOG2E : -1e30f;
        wave_attend(lds, 16 * wave, 16 * wave, beta > 0 ? 0 : 128, qf, sk, isA, o, mrow, lrow, lane);
        if (isA) {
            bf16* op = (bf16*)(ws + WS_OA) + qtok * 512 + qcol + h * 64 + 4 * g;
#pragma unroll
            for (int c = 0; c < 4; ++c) { u32x2 w; w.x = pk2(o[c][0], o[c][1]); w.y = pk2(o[c][2], o[c][3]); *(u32x2*)(op + 16 * c) = w; }
        } else {
            bf16* op = (bf16*)(ws + WS_OBG) + ((size_t)grp * TT + qtok) * 256 + slot * 64 + 4 * g;
#pragma unroll
            for (int c = 0; c < 4; ++c) { u32x2 w; w.x = pk2(o[c][0], o[c][1]); w.y = pk2(o[c][2], o[c][3]); *(u32x2*)(op + 16 * c) = w; }
            if (g == 0) ((float*)(ws + WS_LSE))[((size_t)grp * TT + qtok) * 4 + slot] = LN2 * (mrow + __builtin_amdgcn_logf(lrow));
        }
    }
}

__device__ __forceinline__ void sample_task(const float* cache, const float* newrows, int lb, int dil, int qi, int rowf, int koff, int voff, f32x4 q, float& m, float& l, f32x4& o) {
#pragma unroll 4
    for (int j = 0; j < 128; ++j) {
        const int off = qi - dil * j;
        const float* rp = off >= 0 ? newrows + (size_t)off * rowf : cache + (size_t)(lb + off) * rowf;
        const f32x4 k4 = *(const f32x4*)(rp + koff), v4 = *(const f32x4*)(rp + voff);
        float s = (q[0] * k4[0] + q[1] * k4[1]) + (q[2] * k4[2] + q[3] * k4[3]);
        s = row16_sum(s);
        const float mn = fmaxf(m, s), sc = __builtin_amdgcn_exp2f(m - mn), p = __builtin_amdgcn_exp2f(s - mn);
        l = l * sc + p; o = o * sc + v4 * p; m = mn;
    }
}
__device__ __forceinline__ void sample_tasks(const Args& a, int gw, int NGW, int lane) {
    unsigned char* ws = a.ws; const bf16* P = (const bf16*)(ws + WS_PROJ);
    const int t = lane >> 4, dd = 4 * (lane & 15);
    for (int task = gw; task < 2560; task += NGW) {
        if (task < 1536) {
            const int grp = task % 3, nq = task / 3, n = nq >> 2, qi = nq & 3, lb = 128 << (2 * grp), dil = 1 << (2 * grp);
            const float* cache = a.in[3 + grp] + (size_t)n * lb * 512;
            const size_t os = grp == 0 ? O_CB1_S : (grp == 1 ? O_CB2_S : O_CB3_S);
            const float* newrows = a.out + os + (size_t)n * 4 * 512;
            const size_t row = (size_t)TP + nq;
            const u32x2 qw = *(const u32x2*)(P + row * NPROJ + 768 + (4 * grp + t) * 64 + dd);
            const f32x4 q = (f32x4){bflo(qw.x), bfhi(qw.x), bflo(qw.y), bfhi(qw.y)};
            float m = -1e30f, l = 0.f; f32x4 o = (f32x4){0.f, 0.f, 0.f, 0.f};
            sample_task(cache, newrows, lb, dil, qi, 512, 64 * t + dd, 256 + 64 * t + dd, q, m, l, o);
            o = o * (1.0f / l);
            u32x2 w; w.x = pk2(o[0], o[1]); w.y = pk2(o[2], o[3]);
            *(u32x2*)((bf16*)(ws + WS_OBG) + ((size_t)grp * TT + row) * 256 + t * 64 + dd) = w;
            if ((lane & 15) == 0) ((float*)(ws + WS_LSE))[((size_t)grp * TT + row) * 4 + t] = LN2 * (m + __builtin_amdgcn_logf(l));
        } else {
            const int v = task - 1536, half = v & 1, nq = v >> 1, n = nq >> 2, qi = nq & 3;
            const int kvh = t >> 1, qh = 4 * kvh + 2 * half + (t & 1);
            const float* cache = a.in[2] + (size_t)n * 128 * 256;
            const float* newrows = a.out + O_CA_S + (size_t)n * 4 * 256;
            const size_t row = (size_t)TP + nq;
            const u32x2 qw = *(const u32x2*)(P + row * NPROJ + qh * 64 + dd);
            const f32x4 q = (f32x4){bflo(qw.x), bfhi(qw.x), bflo(qw.y), bfhi(qw.y)};
            float m = a.in[8][qh] * LOG2E, l = 1.0f; f32x4 o = (f32x4){0.f, 0.f, 0.f, 0.f};
            sample_task(cache, newrows, 128, 1, qi, 256, 64 * kvh + dd, 128 + 64 * kvh + dd, q, m, l, o);
            o = o * (1.0f / l);
            u32x2 w; w.x = pk2(o[0], o[1]); w.y = pk2(o[2], o[3]);
            *(u32x2*)((bf16*)(ws + WS_OA) + row * 512 + qh * 64 + dd) = w;
        }
    }
}
}

__device__ __forceinline__ void combine_pass(const Args& a, int gtid, int NGT) {
    unsigned char* ws = a.ws; const bf16* OBG = (const bf16*)(ws + WS_OBG); const float* LSE = (const float*)(ws + WS_LSE); bf16* OB = (bf16*)(ws + WS_OB);
    for (int it = gtid; it < TT * 32; it += NGT) {
        const int row = it >> 5, c8 = (it & 31) * 8, slot = c8 >> 6;
        const float l0 = LSE[((size_t)0 * TT + row) * 4 + slot], l1 = LSE[((size_t)1 * TT + row) * 4 + slot], l2 = LSE[((size_t)2 * TT + row) * 4 + slot];
        const float mx = fmaxf(l0, fmaxf(l1, l2));
        float w0 = __expf(l0 - mx), w1 = __expf(l1 - mx), w2 = __expf(l2 - mx); const float inv = 1.0f / (w0 + w1 + w2); w0 *= inv; w1 *= inv; w2 *= inv;
        const u32x4 a0 = *(const u32x4*)(OBG + ((size_t)0 * TT + row) * 256 + c8), a1 = *(const u32x4*)(OBG + ((size_t)1 * TT + row) * 256 + c8), a2 = *(const u32x4*)(OBG + ((size_t)2 * TT + row) * 256 + c8);
        u32x4 r;
#pragma unroll
        for (int k = 0; k < 4; ++k) r[k] = pk2(w0 * bflo(a0[k]) + w1 * bflo(a1[k]) + w2 * bflo(a2[k]), w0 * bfhi(a0[k]) + w1 * bfhi(a1[k]) + w2 * bfhi(a2[k]));
        *(u32x4*)(OB + (size_t)row * 256 + c8) = r;
    }
}
__device__ __forceinline__ void ln_row(const float* zr, const float* gam, const float* bet, int lane, f32x4 (&y)[4]) {
    const f32x4* z4 = (const f32x4*)zr + lane; f32x4 v[4]; float s = 0.f;
#pragma unroll
    for (int j = 0; j < 4; ++j) { v[j] = z4[64 * j]; s += (v[j][0] + v[j][1]) + (v[j][2] + v[j][3]); }
    const float mean = wave_sum(s) * (1.f / DM); float s2 = 0.f;
#pragma unroll
    for (int j = 0; j < 4; ++j) { v[j] = v[j] - mean; s2 += (v[j][0] * v[j][0] + v[j][1] * v[j][1]) + (v[j][2] * v[j][2] + v[j][3] * v[j][3]); }
    const float rstd = 1.f / sqrtf(wave_sum(s2) * (1.f / DM) + LN_EPS);
#pragma unroll
    for (int j = 0; j < 4; ++j) { const f32x4 gv = ((const f32x4*)gam + lane)[64 * j], bv = ((const f32x4*)bet + lane)[64 * j]; y[j] = v[j] * rstd * gv + bv; }
}
__device__ __forceinline__ void ln1_pass(const Args& a, int gw, int NGW, int lane) {
    const float* Z = (const float*)(a.ws + WS_Z1); bf16* HB = (bf16*)(a.ws + WS_HB);
    for (int m = gw; m < TT; m += NGW) {
        f32x4 y[4]; ln_row(Z + (size_t)m * DM, a.in[12], a.in[13], lane, y);
        unsigned long long* o8 = (unsigned long long*)(HB + (size_t)m * DM) + lane;
#pragma unroll
        for (int j = 0; j < 4; ++j) o8[64 * j] = (unsigned long long)pk2(y[j][0], y[j][1]) | ((unsigned long long)pk2(y[j][2], y[j][3]) << 32);
    }
}
__device__ __forceinline__ void ln2_pass(const Args& a, int gw, int NGW, int lane) {
    for (int m = gw; m < TT; m += NGW) {
        float* yr = a.out + (size_t)m * DM;
        f32x4 y[4]; ln_row(yr, a.in[18], a.in[19], lane, y);
#pragma unroll
        for (int j = 0; j < 4; ++j) ((f32x4*)yr + lane)[64 * j] = y[j];
    }
}
__device__ __forceinline__ float gelu_exact(float x) { return 0.5f * x * (1.0f + erff(x * 0.70710678118654752f)); }
__device__ __forceinline__ void conv_pass(const Args& a, int gtid, int NGT) {
    const bf16* UV = (const bf16*)(a.ws + WS_UV); bf16* G = (bf16*)(a.ws + WS_G);
    const float* cw = a.in[15]; const float* cb = a.in[16]; const float* st = a.in[6];
    for (int it = gtid; it < TT * (FF / 8); it += NGT) {
        const int row = it / (FF / 8), c = (it % (FF / 8)) * 8;
        const int uc = ((c >> 7) << 8) + (c & 127);
        const u32x4 u0 = *(const u32x4*)(UV + (size_t)row * NUP + uc), vv = *(const u32x4*)(UV + (size_t)row * NUP + uc + 128);
        float u1[8], u2[8];
        int tpos; const float* s1 = nullptr; const float* s2 = nullptr;
        if (row < TP) tpos = row & (SEQ - 1); else { tpos = row & 3; const int n = (row - TP) >> 2; s2 = st + ((size_t)n * 2 + 0) * FF + c; s1 = st + ((size_t)n * 2 + 1) * FF + c; }
        if (tpos >= 1) { const u32x4 w = *(const u32x4*)(UV + (size_t)(row - 1) * NUP + uc);
#pragma unroll
            for (int k = 0; k < 4; ++k) { u1[2 * k] = bflo(w[k]); u1[2 * k + 1] = bfhi(w[k]); } }
        else {
#pragma unroll
            for (int k = 0; k < 8; ++k) u1[k] = s1 ? s1[k] : 0.f; }
        if (tpos >= 2) { const u32x4 w = *(const u32x4*)(UV + (size_t)(row - 2) * NUP + uc);
#pragma unroll
            for (int k = 0; k < 4; ++k) { u2[2 * k] = bflo(w[k]); u2[2 * k + 1] = bfhi(w[k]); } }
        else if (tpos == 1) {
#pragma unroll
            for (int k = 0; k < 8; ++k) u2[k] = s1 ? s1[k] : 0.f; }
        else {
#pragma unroll
            for (int k = 0; k < 8; ++k) u2[k] = s2 ? s2[k] : 0.f; }
        u32x4 r;
#pragma unroll
        for (int k = 0; k < 4; ++k) {
            const int c0 = c + 2 * k, c1 = c0 + 1;
            const float a0 = cw[c0] * u2[2 * k] + cw[FF + c0] * u1[2 * k] + cw[2 * FF + c0] * bflo(u0[k]) + cb[c0];
            const float a1 = cw[c1] * u2[2 * k + 1] + cw[FF + c1] * u1[2 * k + 1] + cw[2 * FF + c1] * bfhi(u0[k]) + cb[c1];
            r[k] = pk2(gelu_exact(a0) * bflo(vv[k]), gelu_exact(a1) * bfhi(vv[k]));
        }
        *(u32x4*)(G + (size_t)row * FF + c) = r;
    }
}

__global__ void __launch_bounds__(NTHREADS, 2) fwd_kernel(Args args) {
    extern __shared__ __attribute__((aligned(16))) unsigned char lds_raw[];
    LAS unsigned char* lds = (LAS unsigned char*)lds_raw;
    const int tid = threadIdx.x, lane = tid & 63, wave = __builtin_amdgcn_readfirstlane(tid >> 6);
    const int G = gridDim.x, bx = blockIdx.x;
    const int vcu = (G % 8 == 0) ? (bx % 8) * (G / 8) + bx / 8 : bx;
    const int gw = vcu * NWAVES + wave, NGW = G * NWAVES, gtid = vcu * NTHREADS + tid, NGT = G * NTHREADS;
    unsigned char* ws = args.ws;
    const int lo = args.ph_lo, hi = args.ph_hi;
#ifndef PHMASK
#define PHMASK 0xfff
#endif
#define IN(k) (((PHMASK >> (k)) & 1) && lo <= (k) && (k) < hi)
#ifndef REPMASK
#define REPMASK 0
#endif
#define REPS(k) ((((REPMASK) >> (k)) & 1) ? 2 : 1)
#define SEAM(k) do { if (IN(k) && IN((k) + 1)) { cg::this_grid().sync(); } } while (0)

    if (IN(0)) for (int rep_ = 0; rep_ < REPS(0); ++rep_) { p0_prologue(args, lds, gw, NGW, wave, lane); }
    SEAM(0);
    if (IN(1)) for (int rep_ = 0; rep_ < REPS(1); ++rep_) {
        pg8::Gemm g{(const pg8::bf16_t*)(ws + WS_XB), (const pg8::bf16_t*)(ws + WS_WIN), TT, NPROJ, DM}; pg8::StaticOrder S; S.init(TT, NPROJ, G, bx);
        pg8::EpiProj E{(pg8::bf16_t*)(ws + WS_PROJ), (const float*)(ws + WS_ROPE), args.out};
        pg8::gemm_phase<pg8::EpiProj, pg8::StaticOrder, true, true>(lds, g, S, E);
    }
    SEAM(1);
    if (IN(2)) for (int rep_ = 0; rep_ < REPS(2); ++rep_) {
        for (int i = tid; i < 16 * att::KP / 4; i += NTHREADS) { ((LAS unsigned*)(lds + att::LDS_K + 256 * att::KP))[i] = 0u; ((LAS unsigned*)(lds + att::LDS_V + 256 * att::KP))[i] = 0u; }
#ifndef REP_PROMPT
#define REP_PROMPT 1
#endif
#ifndef REP_SAMPLE
#define REP_SAMPLE 1
#endif
        for (int rep = 0; rep < REP_PROMPT; ++rep)
        for (int u = vcu; u < 1792; u += G) att::prompt_unit(args, lds, u, tid, wave, lane);
        for (int rep = 0; rep < REP_SAMPLE; ++rep)
        att::sample_tasks(args, gw, NGW, lane);
        __syncthreads();
    }
    SEAM(2);
    if (IN(3)) for (int rep_ = 0; rep_ < REPS(3); ++rep_) { combine_pass(args, gtid, NGT); }
    SEAM(3);
    if (IN(4)) for (int rep_ = 0; rep_ < REPS(4); ++rep_) {
        pg8::Gemm g{(const pg8::bf16_t*)(ws + WS_OA), (const pg8::bf16_t*)(ws + WS_WBRA), TT, DM, 512}; pg8::StaticOrder S; S.init(TT, DM, G, bx);
        pg8::EpiGate<0> E{(const pg8::bf16_t*)(ws + WS_PROJ), nullptr, (pg8::bf16_t*)(ws + WS_T1)};
        pg8::gemm_phase<pg8::EpiGate<0>, pg8::StaticOrder, true, true>(lds, g, S, E);
    }
    SEAM(4);
    if (IN(5)) for (int rep_ = 0; rep_ < REPS(5); ++rep_) {
        pg8::Gemm g{(const pg8::bf16_t*)(ws + WS_OB), (const pg8::bf16_t*)(ws + WS_WBRB), TT, DM, 256}; pg8::StaticOrder S; S.init(TT, DM, G, bx);
        pg8::EpiGate<1> E{(const pg8::bf16_t*)(ws + WS_PROJ), (const pg8::bf16_t*)(ws + WS_T1), (pg8::bf16_t*)(ws + WS_M)};
        pg8::gemm_phase<pg8::EpiGate<1>, pg8::StaticOrder, true, true>(lds, g, S, E);
    }
    SEAM(5);
    if (IN(6)) for (int rep_ = 0; rep_ < REPS(6); ++rep_) {
        pg8::Gemm g{(const pg8::bf16_t*)(ws + WS_M), (const pg8::bf16_t*)(ws + WS_WO), TT, DM, DM}; pg8::StaticOrder S; S.init(TT, DM, G, bx);
        pg8::EpiZ1 E{args.in[0], args.in[1], (float*)(ws + WS_Z1)};
        pg8::gemm_phase<pg8::EpiZ1, pg8::StaticOrder, true, true>(lds, g, S, E);
    }
    SEAM(6);
    if (IN(7)) for (int rep_ = 0; rep_ < REPS(7); ++rep_) { ln1_pass(args, gw, NGW, lane); }
    SEAM(7);
    if (IN(8)) for (int rep_ = 0; rep_ < REPS(8); ++rep_) {
        pg8::Gemm g{(const pg8::bf16_t*)(ws + WS_HB), (const pg8::bf16_t*)(ws + WS_WUP), TT, NUP, DM}; pg8::ConvOrder S; S.init(G, bx);
        pg8::EpiConv E{(pg8::bf16_t*)(ws + WS_G), args.out, args.in[15], args.in[16], args.in[6], (unsigned long long*)(ws + WS_HALO), (LAS float*)(lds + RING_BYTES)};
        pg8::gemm_phase<pg8::EpiConv, pg8::ConvOrder, true, true>(lds, g, S, E);
    }
    if (IN(9)) for (int rep_ = 0; rep_ < REPS(9); ++rep_) { }
    SEAM(9);
    if (IN(10)) for (int rep_ = 0; rep_ < REPS(10); ++rep_) {
        pg8::Gemm g{(const pg8::bf16_t*)(ws + WS_G), (const pg8::bf16_t*)(ws + WS_WDN), TT, DM, FF}; pg8::StaticOrder S; S.init(TT, DM, G, bx);
        pg8::EpiZ2 E{(const pg8::bf16_t*)(ws + WS_HB), args.out};
        pg8::gemm_phase<pg8::EpiZ2, pg8::StaticOrder, true, true>(lds, g, S, E);
    }
    SEAM(10);
    if (IN(11)) for (int rep_ = 0; rep_ < REPS(11); ++rep_) { ln2_pass(args, gw, NGW, lane); }
#undef IN
#undef SEAM
}

#ifndef N_LAUNCH_MODE
#define N_LAUNCH_MODE 1
#endif
extern "C" void kernel_launch(void* const* d_in, const int* in_sizes, int n_in, void* d_out, int out_size, void* d_ws, size_t ws_size, hipStream_t stream) {
    static int grid = 0;
    if (grid == 0) {
        if (n_in != 20 || (size_t)out_size != O_END || ws_size < WS_END) { fprintf(stderr, "kernel_launch: unexpected shapes: n_in %d out %d ws %zu\n", n_in, out_size, ws_size); grid = -1; return; }
        int dev = 0, cus = 0, per_cu = 0;
        if (hipGetDevice(&dev) != hipSuccess || hipDeviceGetAttribute(&cus, hipDeviceAttributeMultiprocessorCount, dev) != hipSuccess) { grid = -1; return; }
        if (hipFuncSetAttribute((const void*)fwd_kernel, hipFuncAttributeMaxDynamicSharedMemorySize, LDS_BYTES) != hipSuccess) { fprintf(stderr, "kernel_launch: hipFuncSetAttribute failed\n"); grid = -1; return; }
        if (hipOccupancyMaxActiveBlocksPerMultiprocessor(&per_cu, (const void*)fwd_kernel, NTHREADS, LDS_BYTES) != hipSuccess || per_cu < 1) { fprintf(stderr, "kernel_launch: occupancy query says %d\n", per_cu); per_cu = 1; }
        (void)hipGetLastError();
        grid = cus;
        if (grid != 256) { fprintf(stderr, "kernel_launch: this kernel needs exactly 256 CUs (got %d)\n", grid); grid = -1; return; }
    }
    if (grid < 0) return;
    Args a{};
    for (int i = 0; i < 20; ++i) a.in[i] = (const float*)d_in[i];
    a.out = (float*)d_out; a.ws = (unsigned char*)d_ws;
    for (int d = 0; d < 32; ++d) a.inv_freq[d] = pow(10000.0, -(double)d / 32.0);
    if (N_LAUNCH_MODE == 1) {
        a.ph_lo = 0; a.ph_hi = NPHASE; a.coop = 1;
        void* kargs[] = {&a};
        hipError_t e = hipLaunchCooperativeKernel((const void*)fwd_kernel, dim3(grid), dim3(NTHREADS), kargs, LDS_BYTES, stream);
        if (e != hipSuccess) fprintf(stderr, "kernel_launch: cooperative launch failed: %s (grid %d)\n", hipGetErrorString(e), grid);
    } else {
        for (int p = 0; p < NPHASE; ++p) {
            a.ph_lo = p; a.ph_hi = p + 1; a.coop = 0;
            hipLaunchKernelGGL(fwd_kernel, dim3(grid), dim3(NTHREADS), LDS_BYTES, stream, a);
        }
    }
}
```

```cpp
#include <hip/hip_runtime.h>
#include <hip/hip_cooperative_groups.h>
#include <cstdio>
#include <cstdint>
#include <cmath>
namespace cg = cooperative_groups;

constexpr int TP = 16384, TS = 512, TT = TP + TS;
constexpr int DM = 1024, NPROJ = 5120, FF = 2816, NUP = 2 * FF;
constexpr int SEQ = 2048, PAST = 16384;
constexpr float ALPHA = 1.189207115002721f;
constexpr float LN_EPS = 1e-5f;
constexpr float QSCALE = 0.125f * 1.4426950408889634f;
constexpr float LOG2E = 1.4426950408889634f, LN2 = 0.6931471805599453f;
constexpr size_t O_Y = 0;
constexpr size_t O_CA_P = (size_t)TT * DM;
constexpr size_t O_CA_S = O_CA_P + 8 * 128 * 2 * 2 * 64;
constexpr size_t O_CB1_P = O_CA_S + 128 * 4 * 2 * 2 * 64;
constexpr size_t O_CB1_S = O_CB1_P + 8 * 128 * 512;
constexpr size_t O_CB2_P = O_CB1_S + 128 * 4 * 512;
constexpr size_t O_CB2_S = O_CB2_P + 8 * 512 * 512;
constexpr size_t O_CB3_P = O_CB2_S + 128 * 4 * 512;
constexpr size_t O_CB3_S = O_CB3_P + (size_t)8 * 2048 * 512;
constexpr size_t O_SC_P = O_CB3_S + 128 * 4 * 512;
constexpr size_t O_SC_S = O_SC_P + 8 * 2 * FF;
constexpr size_t O_END = O_SC_S + 128 * 2 * FF;
constexpr size_t MiB = 1u << 20;
constexpr size_t WS_CTL = 0, WS_ROPE = 1 * MiB, WS_WIN = 2 * MiB, WS_WBR = 12 * MiB  , WS_WO = 14 * MiB, WS_WUP = 16 * MiB, WS_WDN = 27 * MiB;
constexpr size_t WS_XB = 34 * MiB, WS_PROJ = 68 * MiB, WS_OAB = 288 * MiB  , WS_OBG = 252 * MiB, WS_LSE = 277 * MiB;
constexpr size_t WS_M = 322 * MiB, WS_Z1 = 356 * MiB, WS_HB = 422 * MiB, WS_UV = 456 * MiB, WS_HALO = 456 * MiB  , WS_G = 638 * MiB, WS_END = 730 * MiB;

namespace pg8 {
#define PG8_LAS __attribute__((address_space(3)))
typedef unsigned short bf16_t;
typedef short bf16x8 __attribute__((ext_vector_type(8)));
typedef float f32x4 __attribute__((ext_vector_type(4)));
typedef unsigned u32x4 __attribute__((ext_vector_type(4)));
constexpr int BM = 256, BK = 64, HALF = 128, HTB = HALF * BK * 2  , STAGE_BYTES = 8 * HTB, NXCD = 8, WGM = 8;

__host__ __device__ __forceinline__ int lds_byte(int r, int c) { const int st = (r >> 4) * 2 + (c >> 5), rr = r & 15, cc = c & 31, ob = rr * 64 + cc * 2; return st * 1024 + (ob ^ (((ob >> 9) & 1) << 5)); }
__host__ __device__ __forceinline__ void stage_rc(int b, int& R, int& C) { const int st = b / 1024, sb = b % 1024, swz = sb ^ (((sb >> 9) & 1) << 5); R = (st >> 1) * 16 + swz / 64; C = (st & 1) * 32 + (swz % 64) / 2; }
__host__ __device__ __forceinline__ int perm32(int rho) { const int n = rho >> 4, i = rho & 15; return 8 * (i >> 2) + 4 * n + (i & 3); }

struct Unit { int pm, pn; };
struct Gemm { const bf16_t* A; const bf16_t* Bt; int M, N, K; };

struct StaticOrder {
    int nM, nN, nwg, G, c;
    __host__ __device__ void init(int M, int N, int G_, int c_) { nM = M / BM; nN = N / BM; nwg = nM * nN; G = G_; c = c_; }
    __host__ __device__ bool next(int i, Unit& u) const {
        const long L = (long)i * G + c; if (L >= nwg) return false;
        int wgid = (int)L; { const int q = nwg / NXCD, r = nwg % NXCD, xcd = wgid % NXCD, off = wgid / NXCD; wgid = (xcd < r ? xcd * (q + 1) : r * (q + 1) + (xcd - r) * q) + off; }
        const int nig = WGM * nN, gid = wgid / nig, fm = gid * WGM, gsz = (nM - fm) < WGM ? (nM - fm) : WGM;
        u.pm = fm + ((wgid % nig) % gsz); u.pn = (wgid % nig) / gsz; return true;
    }
    __device__ __forceinline__ void a_ready(const Unit&) const {}
    __device__ __forceinline__ void done(const Unit&) const {}
};

__device__ __forceinline__ unsigned cvt_pk_bf16(float lo, float hi) { unsigned r; asm volatile("v_cvt_pk_bf16_f32 %0, %1, %2" : "=v"(r) : "v"(lo), "v"(hi)); return r; }
typedef float f32x2 __attribute__((ext_vector_type(2)));
__device__ __forceinline__ f32x2 gelu_pk(f32x2 v) {
    const f32x2 av = __builtin_elementwise_abs(v), d = av * 0.2316418882f + 1.0f;
    f32x2 t; t.x = __builtin_amdgcn_rcpf(d.x); t.y = __builtin_amdgcn_rcpf(d.y);
    f32x2 q = t * 0.5307027145f + (-0.7265760135f); q = q * t + 0.7107068705f; q = q * t + (-0.142248368f); q = q * t + 0.127414796f; q = q * t;
    const f32x2 s = (v * v) * (-0.72134752044f);
    f32x2 e; e.x = __builtin_amdgcn_exp2f(s.x); e.y = __builtin_amdgcn_exp2f(s.y);
    const f32x2 m = v * (q * e), r = v - m;
    f32x2 o; o.x = v.x < 0.f ? m.x : r.x; o.y = v.y < 0.f ? m.y : r.y; return o;
}

typedef unsigned u32x2 __attribute__((ext_vector_type(2)));
__device__ __forceinline__ float bf_lo(unsigned w) { return __uint_as_float(w << 16); }
__device__ __forceinline__ float bf_hi(unsigned w) { return __uint_as_float(w & 0xffff0000u); }
__device__ __forceinline__ float sigmoidf_(float x) { return __builtin_amdgcn_rcpf(1.0f + __builtin_amdgcn_exp2f(-x * 1.4426950408889634f)); }

struct EpiProj {
    static constexpr bool PERM = false, AFTER_DRAIN = false; static constexpr int MID_T = -1;
    bf16_t* P; const float* rope; float* out;
    __device__ __forceinline__ void operator()(const f32x4 (&acc)[2][2][4][2], const Unit& u, int wr, int wc, int fr, int fq) const {
#pragma unroll
        for (int bj = 0; bj < 2; ++bj) {
            const int hs = 4 * u.pn + 2 * bj + (wc >> 1);
            const int d0 = 16 * (wc & 1) + 4 * fq;
            const bool is_q = (hs < 8) || (hs >= 12 && hs < 24);
            const bool is_k = (hs >= 8 && hs < 10) || (hs >= 24 && hs < 36);
            const bool is_v = (hs >= 10 && hs < 12) || (hs >= 36 && hs < 48);
            const bool do_rope = is_q || is_k;
#pragma unroll
            for (int ai = 0; ai < 2; ++ai)
#pragma unroll
                for (int m = 0; m < 4; ++m) {
                    const int row = u.pm * BM + ai * HALF + wr * 64 + m * 16 + fr;
                    f32x4 v0 = acc[ai][bj][m][0], v1 = acc[ai][bj][m][1];
                    if (do_rope) {
                        const int pidx = row < TP ? (row & (SEQ - 1)) : SEQ + (row & 3);
                        const f32x4* rp = (const f32x4*)(rope + ((size_t)pidx * 32 + d0) * 2);
                        const f32x4 c01 = rp[0], c23 = rp[1];
                        f32x4 o0, o1;
                        o0[0] = v0[0] * c01[0] - v1[0] * c01[1]; o1[0] = v1[0] * c01[0] + v0[0] * c01[1];
                        o0[1] = v0[1] * c01[2] - v1[1] * c01[3]; o1[1] = v1[1] * c01[2] + v0[1] * c01[3];
                        o0[2] = v0[2] * c23[0] - v1[2] * c23[1]; o1[2] = v1[2] * c23[0] + v0[2] * c23[1];
                        o0[3] = v0[3] * c23[2] - v1[3] * c23[3]; o1[3] = v1[3] * c23[2] + v0[3] * c23[3];
                        v0 = o0; v1 = o1;
                    }
                    if (is_k || is_v) {
                        float* dst = nullptr;
                        const int kv = is_v ? 1 : 0;
                        if (hs < 12) {
                            const int kh = (hs - 8) & 1;
                            if (row < TP) { const int b = row >> 11, t = row & (SEQ - 1); if (t >= SEQ - 128) dst = out + O_CA_P + ((((size_t)b * 128 + (t - (SEQ - 128))) * 2 + kv) * 2 + kh) * 64; }
                            else { const int r = row - TP; dst = out + O_CA_S + (((size_t)r * 2 + kv) * 2 + kh) * 64; }
                        } else {
                            const int hb = (hs - 24) % 12, g = hb >> 2, s = hb & 3, lb = 128 << (2 * g);
                            const size_t op = g == 0 ? O_CB1_P : (g == 1 ? O_CB2_P : O_CB3_P), os = g == 0 ? O_CB1_S : (g == 1 ? O_CB2_S : O_CB3_S);
                            if (row < TP) { const int b = row >> 11, t = row & (SEQ - 1); if (t >= SEQ - lb) dst = out + op + ((((size_t)b * lb + (t - (SEQ - lb))) * 2 + kv) * 4 + s) * 64; }
                            else { const int r = row - TP; dst = out + os + (((size_t)r * 2 + kv) * 4 + s) * 64; }
                        }
                        if (dst) { *(f32x4*)(dst + d0) = v0; *(f32x4*)(dst + d0 + 32) = v1; }
                    }
                    if (is_q) { v0 = v0 * QSCALE; v1 = v1 * QSCALE; }
                    bf16_t* pp = P + (size_t)row * NPROJ + hs * 64 + d0;
                    u32x2 w0, w1; w0.x = cvt_pk_bf16(v0[0], v0[1]); w0.y = cvt_pk_bf16(v0[2], v0[3]); w1.x = cvt_pk_bf16(v1[0], v1[1]); w1.y = cvt_pk_bf16(v1[2], v1[3]);
                    *(u32x2*)pp = w0; *(u32x2*)(pp + 32) = w1;
                }
        }
    }
};

struct EpiGateM {
    static constexpr bool PERM = true, AFTER_DRAIN = false; static constexpr int MID_T = 8;
    const bf16_t* P; bf16_t* O;
    __device__ __forceinline__ void mid(f32x4 (&acc)[2][2][4][2], const Unit& u, int wr, int wc, int fr, int fq) const {
        const unsigned loff = (unsigned)((fr * NPROJ + wc * 32 + 8 * fq) * 2);
#pragma unroll
        for (int ai = 0; ai < 2; ++ai)
#pragma unroll
            for (int m = 0; m < 4; ++m)
#pragma unroll
                for (int bj = 0; bj < 2; ++bj) {
                    const char* base = (const char*)(P + (size_t)(u.pm * BM + ai * HALF + m * 16 + wr * 64) * NPROJ + 3072 + u.pn * BM + bj * HALF);
                    const u32x4 ga = *(const u32x4*)(base + loff), gb = *(const u32x4*)(base + 2048 + loff);
#pragma unroll
                    for (int k = 0; k < 4; ++k) {
                        const float r0 = (1.0f + __builtin_amdgcn_exp2f(-bf_lo(gb[k]) * 1.4426950408889634f)) * __builtin_amdgcn_rcpf(1.0f + __builtin_amdgcn_exp2f(-bf_lo(ga[k]) * 1.4426950408889634f));
                        const float r1 = (1.0f + __builtin_amdgcn_exp2f(-bf_hi(gb[k]) * 1.4426950408889634f)) * __builtin_amdgcn_rcpf(1.0f + __builtin_amdgcn_exp2f(-bf_hi(ga[k]) * 1.4426950408889634f));
                        acc[ai][bj][m][k >> 1][2 * (k & 1)] *= r0; acc[ai][bj][m][k >> 1][2 * (k & 1) + 1] *= r1;
                    }
                    asm volatile("" ::: "memory");
                }
    }
    __device__ __forceinline__ void operator()(const f32x4 (&acc)[2][2][4][2], const Unit& u, int wr, int wc, int fr, int fq) const {
        const int row0 = u.pm * BM + wr * 64 + fr, col0 = u.pn * BM + wc * 32 + 8 * fq;
#pragma unroll
        for (int ai = 0; ai < 2; ++ai)
#pragma unroll
            for (int m = 0; m < 4; ++m) {
                const int row = row0 + ai * HALF + m * 16;
#pragma unroll
                for (int bj = 0; bj < 2; ++bj) {
                    const int col = col0 + bj * HALF;
                    const u32x4 gw = *(const u32x4*)(P + (size_t)row * NPROJ + 4096 + col);
                    f32x4 v0 = acc[ai][bj][m][0], v1 = acc[ai][bj][m][1];
                    v0[0] *= sigmoidf_(bf_lo(gw.x)); v0[1] *= sigmoidf_(bf_hi(gw.x)); v0[2] *= sigmoidf_(bf_lo(gw.y)); v0[3] *= sigmoidf_(bf_hi(gw.y));
                    v1[0] *= sigmoidf_(bf_lo(gw.z)); v1[1] *= sigmoidf_(bf_hi(gw.z)); v1[2] *= sigmoidf_(bf_lo(gw.w)); v1[3] *= sigmoidf_(bf_hi(gw.w));
                    u32x4 w; w.x = cvt_pk_bf16(v0[0], v0[1]); w.y = cvt_pk_bf16(v0[2], v0[3]); w.z = cvt_pk_bf16(v1[0], v1[1]); w.w = cvt_pk_bf16(v1[2], v1[3]);
                    *(u32x4*)(O + (size_t)row * DM + col) = w;
                }
                asm volatile("" ::: "memory");
            }
    }
};

struct EpiZ1 {
    static constexpr bool PERM = false, AFTER_DRAIN = false; static constexpr int MID_T = -1;
    const float* xp; const float* xs; float* Z;
    __device__ __forceinline__ void operator()(const f32x4 (&acc)[2][2][4][2], const Unit& u, int wr, int wc, int fr, int fq) const {
        const int row0 = u.pm * BM + wr * 64 + fr, col0 = u.pn * BM + wc * 32 + 4 * fq;
#pragma unroll
        for (int ai = 0; ai < 2; ++ai)
#pragma unroll
            for (int m = 0; m < 4; ++m) {
                const int row = row0 + ai * HALF + m * 16;
                const float* xr = row < TP ? xp + (size_t)row * DM : xs + (size_t)(row - TP) * DM;
#pragma unroll
                for (int bj = 0; bj < 2; ++bj)
#pragma unroll
                    for (int n = 0; n < 2; ++n) { const int col = col0 + bj * HALF + n * 16;
                        const f32x4 xv = *(const f32x4*)(xr + col);
                        *(f32x4*)(Z + (size_t)row * DM + col) = xv * ALPHA + acc[ai][bj][m][n]; }
            }
    }
};

struct EpiUV {
    static constexpr bool PERM = true, AFTER_DRAIN = false; static constexpr int MID_T = -1;
    bf16_t* UV; float* out;
    __device__ __forceinline__ void operator()(const f32x4 (&acc)[2][2][4][2], const Unit& u, int wr, int wc, int fr, int fq) const {
        const int row0 = u.pm * BM + wr * 64 + fr, ct0 = wc * 32 + 8 * fq;
#pragma unroll
        for (int ai = 0; ai < 2; ++ai)
#pragma unroll
            for (int m = 0; m < 4; ++m) {
                const int row = row0 + ai * HALF + m * 16;
#pragma unroll
                for (int bj = 0; bj < 2; ++bj) {
                    const f32x4 v0 = acc[ai][bj][m][0], v1 = acc[ai][bj][m][1];
                    u32x4 w; w.x = cvt_pk_bf16(v0[0], v0[1]); w.y = cvt_pk_bf16(v0[2], v0[3]); w.z = cvt_pk_bf16(v1[0], v1[1]); w.w = cvt_pk_bf16(v1[2], v1[3]);
                    *(u32x4*)(UV + (size_t)row * NUP + u.pn * BM + bj * HALF + ct0) = w;
                    if (bj == 0) {
                        float* dst = nullptr; const int ucol = u.pn * HALF + ct0;
                        if (row < TP) { const int b = row >> 11, t = row & (SEQ - 1); if (t >= SEQ - 2) dst = out + O_SC_P + ((size_t)b * 2 + (t - (SEQ - 2))) * FF + ucol; }
                        else { const int r = row - TP, n = r >> 2, qi = r & 3; if (qi >= 2) dst = out + O_SC_S + ((size_t)n * 2 + (qi - 2)) * FF + ucol; }
                        if (dst) { *(f32x4*)dst = v0; *(f32x4*)(dst + 4) = v1; }
                    }
                }
            }
    }
};

template <int CTRL> __device__ __forceinline__ float dpp_mov(float v) { return __builtin_bit_cast(float, __builtin_amdgcn_update_dpp(0, __builtin_bit_cast(int, v), CTRL, 0xf, 0xf, true)); }
template <int CTRL> __device__ __forceinline__ float dpp_upd(float old, float v) { return __builtin_bit_cast(float, __builtin_amdgcn_update_dpp(__builtin_bit_cast(int, old), __builtin_bit_cast(int, v), CTRL, 0xf, 0xf, false)); }
constexpr unsigned HALO_TAG = 0x5eed0001u;
struct ConvOrder {
    int x, cl, nx;
    __host__ __device__ void init(int G_, int c_) { x = c_ & 7; cl = c_ >> 3; nx = G_ >> 3; }
    __host__ __device__ bool next(int i, Unit& u) const {
        const int Lx = i * nx + cl;
        if (Lx < 176) { u.pm = 8 * x + (Lx & 7); u.pn = Lx >> 3; return true; }
        const int sidx = (Lx - 176) * 8 + x; if (sidx >= 44) return false;
        u.pm = 64 + (sidx & 1); u.pn = sidx >> 1; return true;
    }
    __device__ __forceinline__ void a_ready(const Unit&) const {}
    __device__ __forceinline__ void done(const Unit&) const {}
};
struct EpiConv {
    static constexpr bool PERM = true, AFTER_DRAIN = false; static constexpr int MID_T = -1;
    bf16_t* Gout; float* out; const float* cw; const float* cb; const float* st; unsigned long long* halo; PG8_LAS float* xbuf;
    __device__ __forceinline__ void finish(const f32x4 (&cur)[2], const f32x4 (&t1)[2], const f32x4 (&t2)[2], const f32x4 (&vv)[2], const f32x4 (&w0)[2], const f32x4 (&w1)[2], const f32x4 (&w2)[2], const f32x4 (&bb)[2], bf16_t* dst) const {
        u32x4 w;
#pragma unroll
        for (int n = 0; n < 2; ++n) {
            const f32x4 a = w0[n] * t2[n] + w1[n] * t1[n] + w2[n] * cur[n] + bb[n];
            const f32x2 g0 = gelu_pk((f32x2){a[0], a[1]}), g1 = gelu_pk((f32x2){a[2], a[3]});
            const unsigned lo = cvt_pk_bf16(g0.x * vv[n][0], g0.y * vv[n][1]), hi = cvt_pk_bf16(g1.x * vv[n][2], g1.y * vv[n][3]);
            if (n == 0) { w.x = lo; w.y = hi; } else { w.z = lo; w.w = hi; }
        }
        *(u32x4*)dst = w;
    }
    __device__ __forceinline__ void operator()(const f32x4 (&acc)[2][2][4][2], const Unit& u, int wr, int wc, int fr, int fq) const {
        const int col = u.pn * HALF + wc * 32 + 8 * fq;
        f32x4 w0[2], w1[2], w2[2], bb[2];
#pragma unroll
        for (int n = 0; n < 2; ++n) { w0[n] = *(const f32x4*)(cw + col + 4 * n); w1[n] = *(const f32x4*)(cw + FF + col + 4 * n); w2[n] = *(const f32x4*)(cw + 2 * FF + col + 4 * n); bb[n] = *(const f32x4*)(cb + col + 4 * n); }
        if (u.pm >= 64) {
#pragma unroll
            for (int ai = 0; ai < 2; ++ai)
#pragma unroll
                for (int m = 0; m < 4; ++m) {
                    const int row = u.pm * BM + ai * HALF + wr * 64 + m * 16 + fr, r = row - TP, nb = r >> 2, qi = r & 3;
                    f32x4 cur[2], vv[2], t1[2], t2[2];
#pragma unroll
                    for (int n = 0; n < 2; ++n) {
                        cur[n] = acc[ai][0][m][n]; vv[n] = acc[ai][1][m][n];
                        const f32x4 s0 = *(const f32x4*)(st + ((size_t)nb * 2 + 0) * FF + col + 4 * n), s1 = *(const f32x4*)(st + ((size_t)nb * 2 + 1) * FF + col + 4 * n);
#pragma unroll
                        for (int e = 0; e < 4; ++e) { const float a1 = dpp_mov<0x111>(cur[n][e]), a2 = dpp_mov<0x112>(cur[n][e]);
                            t1[n][e] = qi >= 1 ? a1 : s1[e]; t2[n][e] = qi >= 2 ? a2 : (qi == 1 ? s1[e] : s0[e]); }
                    }
                    if (qi >= 2) { float* dst = out + O_SC_S + ((size_t)nb * 2 + (qi - 2)) * FF + col; *(f32x4*)dst = cur[0]; *(f32x4*)(dst + 4) = cur[1]; }
                    finish(cur, t1, t2, vv, w0, w1, w2, bb, Gout + (size_t)row * FF + col);
                }
            return;
        }
        const int seqtile = u.pm & 7;
        if (wr == 1 && fr >= 14) {
            if (seqtile != 7) {
                unsigned long long* hp = halo + (((size_t)(u.pm * 22 + u.pn) * 4 + wc) * 8 + (fr & 1) * 4 + fq) * 8;
#pragma unroll
                for (int n = 0; n < 2; ++n)
#pragma unroll
                    for (int e = 0; e < 4; ++e) __hip_atomic_store(hp + 4 * n + e, ((unsigned long long)HALO_TAG << 32) | (unsigned long long)__float_as_uint(acc[1][0][3][n][e]), __ATOMIC_RELAXED, __HIP_MEMORY_SCOPE_AGENT);
            } else {
                float* dst = out + O_SC_P + ((size_t)(u.pm >> 3) * 2 + (fr - 14)) * FF + col; *(f32x4*)dst = acc[1][0][3][0]; *(f32x4*)(dst + 4) = acc[1][0][3][1];
            }
        }
        if (fr >= 14) {
#pragma unroll
            for (int ai = 0; ai < 2; ++ai) { PG8_LAS float* xb = xbuf + ((((wr * 4 + wc) * 2 + ai) * 2 + (fr & 1)) * 4 + fq) * 8; *(PG8_LAS f32x4*)xb = acc[ai][0][3][0]; *(PG8_LAS f32x4*)(xb + 4) = acc[ai][0][3][1]; }
        }
        asm volatile("s_waitcnt lgkmcnt(0)" ::: "memory"); __builtin_amdgcn_s_barrier(); asm volatile("" ::: "memory");
#pragma unroll
        for (int ai = 0; ai < 2; ++ai) {
            f32x4 prev[2];
            const int blk = 2 * ai + wr;
            if (blk == 0) {
                prev[0] = (f32x4){0.f, 0.f, 0.f, 0.f}; prev[1] = prev[0];
                if (seqtile != 0) {
                    const unsigned long long* hp = halo + (((size_t)((u.pm - 1) * 22 + u.pn) * 4 + wc) * 8 + (fr & 1) * 4 + fq) * 8;
                    unsigned long long gv[8];
                    for (unsigned spins = 0;; ++spins) {
                        bool ok = true;
#pragma unroll
                        for (int k = 0; k < 8; ++k) { gv[k] = __hip_atomic_load(hp + k, __ATOMIC_RELAXED, __HIP_MEMORY_SCOPE_AGENT); ok &= (unsigned)(gv[k] >> 32) == HALO_TAG; }
                        if (__all(ok) || spins > (1u << 17)) break;
                        __builtin_amdgcn_s_sleep(2);
                    }
#pragma unroll
                    for (int k = 0; k < 8; ++k) prev[k >> 2][k & 3] = __uint_as_float((unsigned)gv[k]);
                }
            } else {
                const int pw = (blk - 1) & 1, pa = (blk - 1) >> 1;
                const PG8_LAS float* xb = xbuf + ((((pw * 4 + wc) * 2 + pa) * 2 + (fr & 1)) * 4 + fq) * 8;
                prev[0] = *(const PG8_LAS f32x4*)xb; prev[1] = *(const PG8_LAS f32x4*)(xb + 4);
            }
#pragma unroll
            for (int m = 0; m < 4; ++m) {
                const int row = u.pm * BM + ai * HALF + wr * 64 + m * 16 + fr;
                f32x4 cur[2], vv[2], t1[2], t2[2];
#pragma unroll
                for (int n = 0; n < 2; ++n) {
                    cur[n] = acc[ai][0][m][n]; vv[n] = acc[ai][1][m][n];
#pragma unroll
                    for (int e = 0; e < 4; ++e) { const float p1 = dpp_mov<0x121>(prev[n][e]), p2 = dpp_mov<0x122>(prev[n][e]);
                        t1[n][e] = dpp_upd<0x111>(p1, cur[n][e]); t2[n][e] = dpp_upd<0x112>(p2, cur[n][e]); }
                }
                finish(cur, t1, t2, vv, w0, w1, w2, bb, Gout + (size_t)row * FF + col);
                prev[0] = cur[0]; prev[1] = cur[1];
            }
        }
    }
};

struct EpiZ2 {
    static constexpr bool PERM = false, AFTER_DRAIN = false; static constexpr int MID_T = -1;
    const bf16_t* HB; float* Y;
    __device__ __forceinline__ void operator()(const f32x4 (&acc)[2][2][4][2], const Unit& u, int wr, int wc, int fr, int fq) const {
        const int row0 = u.pm * BM + wr * 64 + fr, col0 = u.pn * BM + wc * 32 + 4 * fq;
#pragma unroll
        for (int ai = 0; ai < 2; ++ai)
#pragma unroll
            for (int m = 0; m < 4; ++m) {
                const int row = row0 + ai * HALF + m * 16;
#pragma unroll
                for (int bj = 0; bj < 2; ++bj)
#pragma unroll
                    for (int n = 0; n < 2; ++n) { const int col = col0 + bj * HALF + n * 16;
                        const u32x2 hw = *(const u32x2*)(HB + (size_t)row * DM + col);
                        f32x4 hv; hv[0] = bf_lo(hw.x); hv[1] = bf_hi(hw.x); hv[2] = bf_lo(hw.y); hv[3] = bf_hi(hw.y);
                        *(f32x4*)(Y + (size_t)row * DM + col) = hv * ALPHA + acc[ai][bj][m][n]; }
            }
    }
};

template <class Epi, class Sched, bool ALIGN_EPI = false, bool SP2 = false>
__device__ __forceinline__ void gemm_phase(PG8_LAS unsigned char* lds, const Gemm g, const Sched& S, const Epi& E) {
    const int tid = threadIdx.x, wid = __builtin_amdgcn_readfirstlane(tid >> 6), lane = tid & 63, wr = wid >> 2, wc = wid & 3, fr = lane & 15, fq = lane >> 4;
    int K = g.K; asm volatile("" : "+s"(K));
    const int nt = K / BK;
    unsigned voffA[2], voffB[2];
#pragma unroll
    for (int i = 0; i < 2; ++i) { int R, C; stage_rc(tid * 16 + i * 8192, R, C); const int Rb = Epi::PERM ? ((R & ~31) + perm32(R & 31)) : R;
        voffA[i] = (unsigned)(R * K + C) * 2u; voffB[i] = (unsigned)(Rb * K + C) * 2u; }
    const size_t kstep = (size_t)(BK * 2);
    const size_t hstep = (size_t)HALF * K * 2;
    const size_t tstep = 2 * hstep;
    const unsigned ldsw = (unsigned)wid * 1024u;
    const int aoff = lds_byte(wr * 64 + fr, fq * 8), boff = lds_byte(wc * 32 + fr, fq * 8);
#define PG8_SA(b, h) (((b) * 2 + (h)) * HTB)
#define PG8_SB(b, h) ((4 + (b) * 2 + (h)) * HTB)
#define PG8_STAGE(bufoff, gbase, voff) do { _Pragma("unroll") for (int _i = 0; _i < 2; ++_i) \
        __builtin_amdgcn_global_load_lds((const unsigned*)((const char*)(gbase) + (voff)[_i]), (PG8_LAS unsigned*)(lds + (bufoff) + ldsw + _i * 8192), 16, 0, 0); } while (0)
#define PG8_LDA(dst, b, h) do { _Pragma("unroll") for (int m = 0; m < 4; ++m) _Pragma("unroll") for (int k = 0; k < 2; ++k) dst[m][k] = *(const PG8_LAS bf16x8*)(lds + PG8_SA(b, h) + aoff + m * 2048 + k * 1024); } while (0)
#define PG8_LDB(dst, b, h) do { _Pragma("unroll") for (int n = 0; n < 2; ++n) _Pragma("unroll") for (int k = 0; k < 2; ++k) dst[n][k] = *(const PG8_LAS bf16x8*)(lds + PG8_SB(b, h) + boff + n * 2048 + k * 1024); } while (0)
#define PG8_MMA(ai, bj, At, Bt) do { __builtin_amdgcn_s_setprio(1); _Pragma("unroll") for (int m = 0; m < 4; ++m) _Pragma("unroll") for (int n = 0; n < 2; ++n) _Pragma("unroll") for (int k = 0; k < 2; ++k) \
        acc[ai][bj][m][n] = __builtin_amdgcn_mfma_f32_16x16x32_bf16(Bt[n][k], At[m][k], acc[ai][bj][m][n], 0, 0, 0); __builtin_amdgcn_s_setprio(0); } while (0)
#define PG8_WAIT_V(n) asm volatile("s_waitcnt vmcnt(" #n ")" ::: "memory")
#define PG8_WAIT_L(n) asm volatile("s_waitcnt lgkmcnt(" #n ")" ::: "memory")
#define PG8_BAR __builtin_amdgcn_s_barrier()
#define PG8_SCHED __builtin_amdgcn_sched_barrier(0)
    Unit cur, nxt; int ui = 0;
    if (!S.next(0, cur)) return;
    f32x4 acc[2][2][4][2];
#pragma unroll
    for (int a = 0; a < 2; ++a)
#pragma unroll
        for (int b = 0; b < 2; ++b)
#pragma unroll
            for (int m = 0; m < 4; ++m)
#pragma unroll
                for (int n = 0; n < 2; ++n) acc[a][b][m][n] = (f32x4){0.f, 0.f, 0.f, 0.f};
    bf16x8 At[4][2], B0[2][2], B1[2][2];
    const char* cA = (const char*)g.A + (size_t)cur.pm * tstep; const char* cB = (const char*)g.Bt + (size_t)cur.pn * tstep;
    S.a_ready(cur);
    if constexpr (SP2) {
        PG8_STAGE(PG8_SB(0, 0), cB, voffB); PG8_STAGE(PG8_SB(0, 1), cB + hstep, voffB); PG8_STAGE(PG8_SA(0, 0), cA, voffA); PG8_STAGE(PG8_SA(0, 1), cA + hstep, voffA);
        if (wr == 1) PG8_BAR;
        PG8_WAIT_V(2); PG8_BAR;
        PG8_STAGE(PG8_SB(1, 0), cB + kstep, voffB); PG8_STAGE(PG8_SA(1, 0), cA + kstep, voffA); PG8_STAGE(PG8_SB(1, 1), cB + hstep + kstep, voffB);
        PG8_WAIT_V(6); PG8_BAR;
    } else {
        PG8_STAGE(PG8_SB(0, 0), cB, voffB); PG8_STAGE(PG8_SA(0, 0), cA, voffA); PG8_STAGE(PG8_SB(0, 1), cB + hstep, voffB); PG8_STAGE(PG8_SA(0, 1), cA + hstep, voffA);
        if (wr == 1) PG8_BAR;
        PG8_WAIT_V(4); PG8_BAR;
        PG8_STAGE(PG8_SB(1, 0), cB + kstep, voffB); PG8_STAGE(PG8_SA(1, 0), cA + kstep, voffA); PG8_STAGE(PG8_SB(1, 1), cB + hstep + kstep, voffB);
        PG8_WAIT_V(6); PG8_BAR;
    }
    for (;;) {
        const bool has_next = S.next(ui + 1, nxt);
        const char* nA = has_next ? (const char*)g.A + (size_t)nxt.pm * tstep : cA; const char* nB = has_next ? (const char*)g.Bt + (size_t)nxt.pn * tstep : cB;
        constexpr int NSEG = Epi::MID_T >= 0 ? 2 : 1;
#pragma unroll
        for (int seg = 0; seg < NSEG; ++seg) {
        const int tb = (seg == 0) ? 0 : Epi::MID_T, te = (NSEG == 2 && seg == 0) ? Epi::MID_T : nt;
        for (int t = tb; t < te; t += 2) {
            const bool last = (t == nt - 2);
            const char* a1 = cA + (size_t)(t + 1) * kstep;
            const char* a2 = last ? nA : cA + (size_t)(t + 2) * kstep; const char* b2 = last ? nB : cB + (size_t)(t + 2) * kstep;
            const char* a3 = a2 + kstep; const char* b3 = b2 + kstep;
            if (last && has_next) S.a_ready(nxt);
            if constexpr (SP2) {
            PG8_LDB(B0, 0, 0); PG8_LDB(B1, 0, 1); PG8_SCHED; PG8_LDA(At, 0, 0); PG8_STAGE(PG8_SA(1, 1), a1 + hstep, voffA);
            PG8_WAIT_V(8); PG8_WAIT_L(0); PG8_BAR; PG8_MMA(0, 0, At, B0); PG8_MMA(0, 1, At, B1); PG8_BAR; PG8_SCHED;
            PG8_LDA(At, 0, 1); PG8_STAGE(PG8_SB(0, 0), b2, voffB); PG8_STAGE(PG8_SB(0, 1), b2 + hstep, voffB); PG8_STAGE(PG8_SA(0, 0), a2, voffA);
            PG8_WAIT_V(8); PG8_WAIT_L(0); PG8_BAR; PG8_MMA(1, 0, At, B0); PG8_MMA(1, 1, At, B1); PG8_BAR; PG8_SCHED;
            PG8_LDB(B0, 1, 0); PG8_LDB(B1, 1, 1); PG8_SCHED; PG8_LDA(At, 1, 0); PG8_STAGE(PG8_SA(0, 1), a2 + hstep, voffA);
            PG8_WAIT_V(8); PG8_WAIT_L(0); PG8_BAR; PG8_MMA(0, 0, At, B0); PG8_MMA(0, 1, At, B1); PG8_BAR; PG8_SCHED;
            PG8_LDA(At, 1, 1); PG8_STAGE(PG8_SB(1, 0), b3, voffB); PG8_STAGE(PG8_SB(1, 1), b3 + hstep, voffB); PG8_STAGE(PG8_SA(1, 0), a3, voffA);
            PG8_WAIT_V(8); PG8_WAIT_L(0); PG8_BAR; PG8_MMA(1, 0, At, B0); PG8_MMA(1, 1, At, B1); PG8_BAR; PG8_SCHED;
            } else {
            PG8_LDB(B0, 0, 0); PG8_SCHED; PG8_LDA(At, 0, 0); PG8_STAGE(PG8_SA(1, 1), a1 + hstep, voffA);
            PG8_WAIT_L(8); PG8_BAR; PG8_WAIT_L(0); PG8_MMA(0, 0, At, B0); PG8_BAR; PG8_SCHED;
            PG8_LDB(B1, 0, 1); PG8_STAGE(PG8_SB(0, 0), b2, voffB);
            PG8_BAR; PG8_WAIT_L(0); PG8_MMA(0, 1, At, B1); PG8_BAR;
            PG8_LDA(At, 0, 1); PG8_STAGE(PG8_SA(0, 0), a2, voffA);
            PG8_BAR; PG8_WAIT_L(0); PG8_MMA(1, 0, At, B0); PG8_BAR; PG8_SCHED;
            PG8_STAGE(PG8_SB(0, 1), b2 + hstep, voffB);
            PG8_WAIT_V(6); PG8_BAR; PG8_MMA(1, 1, At, B1); PG8_BAR;
            PG8_LDB(B0, 1, 0); PG8_SCHED; PG8_LDA(At, 1, 0); PG8_STAGE(PG8_SA(0, 1), a2 + hstep, voffA);
            PG8_WAIT_L(8); PG8_BAR; PG8_WAIT_L(0); PG8_MMA(0, 0, At, B0); PG8_BAR; PG8_SCHED;
            PG8_LDB(B1, 1, 1); PG8_STAGE(PG8_SB(1, 0), b3, voffB);
            PG8_BAR; PG8_WAIT_L(0); PG8_MMA(0, 1, At, B1); PG8_BAR;
            PG8_LDA(At, 1, 1); PG8_STAGE(PG8_SA(1, 0), a3, voffA);
            PG8_BAR; PG8_WAIT_L(0); PG8_MMA(1, 0, At, B0); PG8_BAR; PG8_SCHED;
            PG8_STAGE(PG8_SB(1, 1), b3 + hstep, voffB);
            PG8_WAIT_V(6); PG8_BAR; PG8_MMA(1, 1, At, B1); PG8_BAR;
            }
        }
        if constexpr (NSEG == 2) { if (seg == 0) E.mid(acc, cur, wr, wc, fr, fq); }
        }
        if constexpr (ALIGN_EPI) { if (wr == 0) PG8_BAR; }
        if constexpr (!Epi::AFTER_DRAIN) { E(acc, cur, wr, wc, fr, fq); S.done(cur); }
        if (!has_next) break;
#pragma unroll
        for (int a = 0; a < 2; ++a)
#pragma unroll
            for (int b = 0; b < 2; ++b)
#pragma unroll
                for (int m = 0; m < 4; ++m)
#pragma unroll
                    for (int n = 0; n < 2; ++n) acc[a][b][m][n] = (f32x4){0.f, 0.f, 0.f, 0.f};
        cur = nxt; cA = nA; cB = nB; ++ui;
        if constexpr (ALIGN_EPI) { if (wr == 1) PG8_BAR; }
    }
    PG8_WAIT_V(0);
    if constexpr (!ALIGN_EPI) { if (wr == 0) PG8_BAR; }
    PG8_BAR;
    if constexpr (Epi::AFTER_DRAIN) { E.fused(acc, cur, wr, wc, fr, fq, lds, wid, lane); S.done(cur); }
#undef PG8_SA
#undef PG8_SB
#undef PG8_STAGE
#undef PG8_LDA
#undef PG8_LDB
#undef PG8_MMA
#undef PG8_WAIT_V
#undef PG8_WAIT_L
#undef PG8_BAR
#undef PG8_SCHED
}
}

#define LAS __attribute__((address_space(3)))
typedef unsigned short bf16;
typedef float f32x4 __attribute__((ext_vector_type(4)));
typedef short bf16x8 __attribute__((ext_vector_type(8)));
typedef short s16x4 __attribute__((ext_vector_type(4)));
typedef unsigned u32x4 __attribute__((ext_vector_type(4)));
typedef unsigned u32x2 __attribute__((ext_vector_type(2)));
constexpr int NWAVES = 8, NTHREADS = 512;
constexpr int RING_BYTES = 131072, LDS_BYTES = 147456;
constexpr int NPHASE = 12;

__device__ __forceinline__ unsigned f2bf(float f) { unsigned u = __builtin_bit_cast(unsigned, f); return (u + 0x7fffu + ((u >> 16) & 1u)) >> 16; }
__device__ __forceinline__ unsigned pk2(float lo, float hi) { return f2bf(lo) | (f2bf(hi) << 16); }
__device__ __forceinline__ float bflo(unsigned w) { return __uint_as_float(w << 16); }
__device__ __forceinline__ float bfhi(unsigned w) { return __uint_as_float(w & 0xffff0000u); }
__device__ __forceinline__ float wave_sum(float v) {
#pragma unroll
    for (int o = 1; o < 64; o <<= 1) v += __shfl_xor(v, o);
    return v;
}
template <int CTRL> __device__ __forceinline__ float dppf(float v) { return __builtin_bit_cast(float, __builtin_amdgcn_update_dpp(0, __builtin_bit_cast(int, v), CTRL, 0xf, 0xf, true)); }
__device__ __forceinline__ float row16_sum(float v) {
    v += dppf<0xB1>(v);
    v += dppf<0x4E>(v);
    v += dppf<0x141>(v);
    v += dppf<0x140>(v);
    return v;
}

struct Args { const float* in[20]; float* out; unsigned char* ws; double inv_freq[32]; int ph_lo, ph_hi, coop, pad; };

template <int MAP> __device__ __forceinline__ int rowmap(int n) {
    if (MAP == 1) { const int blk = n >> 6, o = n & 63, nn = o >> 5, half = (o >> 4) & 1, q = o & 15; return (blk << 6) + 32 * half + 16 * nn + q; }
    if (MAP == 2) { return n < FF ? ((n >> 7) << 8) + (n & 127) : (((n - FF) >> 7) << 8) + 128 + ((n - FF) & 127); }
    return n;
}
template <int MAP> __device__ __forceinline__ void p0_transpose_item(const float* W, int K, int N, bf16* WT, LAS float* scr, int item, int lane, int ldt = 0) {
    if (ldt == 0) ldt = K;
    const int nblk = N / 32, kb = item / nblk, nb = item % nblk, k0 = 64 * kb, n0 = 32 * nb;
#pragma unroll 8
    for (int i = 0; i < 32; ++i) { const int kk = 2 * i + (lane >> 5); scr[kk * 33 + (lane & 31)] = W[(size_t)(k0 + kk) * N + n0 + (lane & 31)]; }
    asm volatile("s_waitcnt lgkmcnt(0)" ::: "memory");
    const int c = lane & 7;
#pragma unroll
    for (int j = 0; j < 4; ++j) { const int n = (lane >> 3) + 8 * j; const LAS float* s = scr + (8 * c) * 33 + n;
        u32x4 o; o.x = pk2(s[0 * 33], s[1 * 33]); o.y = pk2(s[2 * 33], s[3 * 33]); o.z = pk2(s[4 * 33], s[5 * 33]); o.w = pk2(s[6 * 33], s[7 * 33]);
        *(u32x4*)(WT + (size_t)rowmap<MAP>(n0 + n) * ldt + k0 + 8 * c) = o; }
    asm volatile("s_waitcnt lgkmcnt(0)" ::: "memory");
}
__device__ __forceinline__ void p0_prologue(const Args& a, LAS unsigned char* lds, int gw, int NGW, int wave, int lane) {
    unsigned char* ws = a.ws;
    LAS float* scr = (LAS float*)(lds + wave * 16384);
    constexpr int I_IN = (DM / 64) * (NPROJ / 32), I_BA = (512 / 64) * (DM / 32), I_BB = (256 / 64) * (DM / 32), I_O = (DM / 64) * (DM / 32), I_UP = (DM / 64) * (NUP / 32), I_DN = (FF / 64) * (DM / 32);
    constexpr int NITEMS = I_IN + I_BA + I_BB + I_O + I_UP + I_DN;
    for (int it = gw; it < NITEMS; it += NGW) {
        int r = it;
        if (r < I_IN) { p0_transpose_item<1>(a.in[7], DM, NPROJ, (bf16*)(ws + WS_WIN), scr, r, lane); continue; } r -= I_IN;
        if (r < I_BA) { p0_transpose_item<0>(a.in[9], 512, DM, (bf16*)(ws + WS_WBR), scr, r, lane, 768); continue; } r -= I_BA;
        if (r < I_BB) { p0_transpose_item<0>(a.in[10], 256, DM, (bf16*)(ws + WS_WBR) + 512, scr, r, lane, 768); continue; } r -= I_BB;
        if (r < I_O) { p0_transpose_item<0>(a.in[11], DM, DM, (bf16*)(ws + WS_WO), scr, r, lane); continue; } r -= I_O;
        if (r < I_UP) { p0_transpose_item<2>(a.in[14], DM, NUP, (bf16*)(ws + WS_WUP), scr, r, lane); continue; } r -= I_UP;
        p0_transpose_item<0>(a.in[17], FF, DM, (bf16*)(ws + WS_WDN), scr, r, lane);
    }
    bf16* XB = (bf16*)(ws + WS_XB);
    for (int m = gw; m < TT; m += NGW) {
        const float* xr = m < TP ? a.in[0] + (size_t)m * DM : a.in[1] + (size_t)(m - TP) * DM;
        const f32x4* x4 = (const f32x4*)xr + lane; unsigned long long* o8 = (unsigned long long*)(XB + (size_t)m * DM) + lane;
#pragma unroll
        for (int j = 0; j < 4; ++j) { const f32x4 v = x4[64 * j]; o8[64 * j] = (unsigned long long)pk2(v[0], v[1]) | ((unsigned long long)pk2(v[2], v[3]) << 32); }
    }
    { unsigned long long* hz = (unsigned long long*)(ws + WS_HALO); for (int i = gw * 64 + lane; i < 64 * 22 * 256; i += NGW * 64) hz[i] = 0ull; }
    float* rope = (float*)(ws + WS_ROPE);
    for (int e = gw * 64 + lane; e < 2052 * 32; e += NGW * 64) {
        const int p = e >> 5, d = e & 31; const double pos = (double)(p < SEQ ? p : PAST + (p - SEQ));
        const double ang = pos * a.inv_freq[d];
        const double k = rint(ang * 0.15915494309189535);
        double r = fma(-k, 6.283185307179586, ang); r = fma(-k, 2.4492935982947064e-16, r);
        rope[2 * e] = (float)cos(r); rope[2 * e + 1] = (float)sin(r);
    }
}

namespace att {
constexpr int KP = 144, NROW = 272;
constexpr int LDS_K = 0, LDS_V = NROW * KP, LDS_END = 2 * NROW * KP;
static_assert(LDS_END <= RING_BYTES, "attention LDS");
__device__ __forceinline__ void stage_kv(const bf16* Kg, const bf16* Vg, long rstride, bool lowvalid, LAS unsigned char* lds, int tid) {
    const int ch = tid & 7;
#pragma unroll
    for (int it = 0; it < 4; ++it) {
        const int j = (tid >> 3) + 64 * it; const bool ok = lowvalid || j >= 128;
        u32x4 kv = (u32x4){0u, 0u, 0u, 0u}, vv = (u32x4){0u, 0u, 0u, 0u};
        if (ok) { kv = *(const u32x4*)(Kg + (long)j * rstride + ch * 8); vv = *(const u32x4*)(Vg + (long)j * rstride + ch * 8); }
        *(LAS u32x4*)(lds + LDS_K + j * KP + ch * 16) = kv; *(LAS u32x4*)(lds + LDS_V + j * KP + ch * 16) = vv;
    }
}
__device__ __forceinline__ void wave_attend(const LAS unsigned char* lds, int kb0, int ibase, int jmin, const bf16x8 (&qf)[2], float sink2, bool has_sink, f32x4 (&o)[4], float& mrow, float& lrow, int lane) {
    const int g = lane >> 4, ql = lane & 15;
    f32x4 st[5][2];
    const LAS unsigned char* kbase = lds + LDS_K + (kb0 + 8 * (ql >> 2) + (ql & 3)) * KP + 16 * g;
#pragma unroll
    for (int s = 0; s < 5; ++s)
#pragma unroll
        for (int t = 0; t < 2; ++t) {
            f32x4 acc = (f32x4){0.f, 0.f, 0.f, 0.f};
#pragma unroll
            for (int ks = 0; ks < 2; ++ks) { const bf16x8 kf = *(const LAS bf16x8*)(kbase + (32 * s + 4 * t) * KP + 64 * ks);
                acc = __builtin_amdgcn_mfma_f32_16x16x32_bf16(kf, qf[ks], acc, 0, 0, 0); }
            st[s][t] = acc;
        }
    float mx = -1e30f;
#pragma unroll
    for (int s = 0; s < 5; ++s)
#pragma unroll
        for (int t = 0; t < 2; ++t)
#pragma unroll
            for (int r = 0; r < 4; ++r) { const int j = kb0 + 32 * s + 8 * g + 4 * t + r, rel = j - (ibase + ql);
                const bool ok = rel >= 1 && rel <= 128 && j >= jmin; const float x = ok ? st[s][t][r] : -1e30f; st[s][t][r] = x; mx = fmaxf(mx, x); }
    mx = fmaxf(mx, __shfl_xor(mx, 16)); mx = fmaxf(mx, __shfl_xor(mx, 32));
    if (has_sink) mx = fmaxf(mx, sink2);
    float sum = 0.f; bf16x8 pf[5];
#pragma unroll
    for (int s = 0; s < 5; ++s) {
        float p[8];
#pragma unroll
        for (int t = 0; t < 2; ++t)
#pragma unroll
            for (int r = 0; r < 4; ++r) { p[4 * t + r] = __builtin_amdgcn_exp2f(st[s][t][r] - mx); sum += p[4 * t + r]; }
        u32x4 w; w.x = pk2(p[0], p[1]); w.y = pk2(p[2], p[3]); w.z = pk2(p[4], p[5]); w.w = pk2(p[6], p[7]);
        pf[s] = __builtin_bit_cast(bf16x8, w);
    }
    sum += __shfl_xor(sum, 16); sum += __shfl_xor(sum, 32);
    const float den = has_sink ? sum + __builtin_amdgcn_exp2f(sink2 - mx) : sum;
    const LAS unsigned char* vbase = lds + LDS_V + (kb0 + 8 * g + (ql >> 2)) * KP + 8 * (lane & 3);
#pragma unroll
    for (int c = 0; c < 4; ++c) {
        f32x4 acc = (f32x4){0.f, 0.f, 0.f, 0.f};
#pragma unroll
        for (int s = 0; s < 5; ++s) {
            const s16x4 lo = __builtin_bit_cast(s16x4, __builtin_amdgcn_ds_read_tr16_b64_v4i16((LAS s16x4*)(vbase + (32 * s) * KP + 32 * c)));
            const s16x4 hi = __builtin_bit_cast(s16x4, __builtin_amdgcn_ds_read_tr16_b64_v4i16((LAS s16x4*)(vbase + (32 * s + 4) * KP + 32 * c)));
            const bf16x8 vf = (bf16x8){lo[0], lo[1], lo[2], lo[3], hi[0], hi[1], hi[2], hi[3]};
            acc = __builtin_amdgcn_mfma_f32_16x16x32_bf16(vf, pf[s], acc, 0, 0, 0);
        }
        const float inv = 1.0f / den;
        o[c] = acc * inv;
    }
    mrow = mx; lrow = sum;
}

__device__ __forceinline__ void prompt_unit(const Args& a, LAS unsigned char* lds, int uidx, int tid, int wave, int lane) {
    unsigned char* ws = a.ws;
    const bf16* P = (const bf16*)(ws + WS_PROJ);
    int b, blk, dil, nq, qcol, kcol, vcol, grp = 0, slot = 0; bool isA;
    if (uidx < 256) { isA = true; b = uidx >> 5; blk = (uidx >> 1) & 15; const int kh = uidx & 1; dil = 1; nq = 4; qcol = kh * 256; kcol = 512 + kh * 64; vcol = 640 + kh * 64; }
    else { const int v = uidx - 256; isA = false; b = v / 192; const int rem = v % 192, hb = rem >> 4; blk = rem & 15; grp = hb >> 2; slot = hb & 3; dil = 1 << (2 * grp); nq = 1;
        qcol = 768 + hb * 64; kcol = 1536 + hb * 64; vcol = 2304 + hb * 64; }
    const int nbr = 16 / dil;
    const int rho = blk / nbr, beta = blk % nbr;
    const long tok0 = (long)b * SEQ + rho + (long)dil * 128 * (beta - 1);
    const long rstride = (long)dil * NPROJ;
    __syncthreads();
    stage_kv(P + tok0 * NPROJ + kcol, P + tok0 * NPROJ + vcol, rstride, beta > 0, lds, tid);
    __syncthreads();
    const int g = lane >> 4, ql = lane & 15;
    const long qtok = tok0 + (long)dil * (128 + 16 * wave + ql);
    const float* sink = a.in[8];
    for (int h = 0; h < nq; ++h) {
        const bf16* qp = P + qtok * NPROJ + qcol + h * 64 + 8 * g;
        bf16x8 qf[2]; qf[0] = *(const bf16x8*)qp; qf[1] = *(const bf16x8*)(qp + 32);
        f32x4 o[4]; float mrow, lrow;
        const float sk = isA ? sink[(qcol >> 6) + h] * LOG2E : -1e30f;
        wave_attend(lds, 16 * wave, 16 * wave, beta > 0 ? 0 : 128, qf, sk, isA, o, mrow, lrow, lane);
        if (isA) {
            bf16* op = (bf16*)(ws + WS_OAB) + qtok * 768 + qcol + h * 64 + 4 * g;
#pragma unroll
            for (int c = 0; c < 4; ++c) { u32x2 w; w.x = pk2(o[c][0], o[c][1]); w.y = pk2(o[c][2], o[c][3]); *(u32x2*)(op + 16 * c) = w; }
        } else {
            bf16* op = (bf16*)(ws + WS_OBG) + ((size_t)grp * TT + qtok) * 256 + slot * 64 + 4 * g;
#pragma unroll
            for (int c = 0; c < 4; ++c) { u32x2 w; w.x = pk2(o[c][0], o[c][1]); w.y = pk2(o[c][2], o[c][3]); *(u32x2*)(op + 16 * c) = w; }
            if (g == 0) ((float*)(ws + WS_LSE))[((size_t)grp * TT + qtok) * 4 + slot] = LN2 * (mrow + __builtin_amdgcn_logf(lrow));
        }
    }
}

__device__ __forceinline__ void sample_task(const float* cache, const float* newrows, int lb, int dil, int qi, int rowf, int koff, int voff, f32x4 q, float& m, float& l, f32x4& o) {
#pragma unroll 4
    for (int j = 0; j < 128; ++j) {
        const int off = qi - dil * j;
        const float* rp = off >= 0 ? newrows + (size_t)off * rowf : cache + (size_t)(lb + off) * rowf;
        const f32x4 k4 = *(const f32x4*)(rp + koff), v4 = *(const f32x4*)(rp + voff);
        float s = (q[0] * k4[0] + q[1] * k4[1]) + (q[2] * k4[2] + q[3] * k4[3]);
        s = row16_sum(s);
        const float mn = fmaxf(m, s), sc = __builtin_amdgcn_exp2f(m - mn), p = __builtin_amdgcn_exp2f(s - mn);
        l = l * sc + p; o = o * sc + v4 * p; m = mn;
    }
}
__device__ __forceinline__ void sample_tasks(const Args& a, int gw, int NGW, int lane) {
    unsigned char* ws = a.ws; const bf16* P = (const bf16*)(ws + WS_PROJ);
    const int t = lane >> 4, dd = 4 * (lane & 15);
    for (int task = gw; task < 2560; task += NGW) {
        if (task < 1536) {
            const int grp = task % 3, nq = task / 3, n = nq >> 2, qi = nq & 3, lb = 128 << (2 * grp), dil = 1 << (2 * grp);
            const float* cache = a.in[3 + grp] + (size_t)n * lb * 512;
            const size_t os = grp == 0 ? O_CB1_S : (grp == 1 ? O_CB2_S : O_CB3_S);
            const float* newrows = a.out + os + (size_t)n * 4 * 512;
            const size_t row = (size_t)TP + nq;
            const u32x2 qw = *(const u32x2*)(P + row * NPROJ + 768 + (4 * grp + t) * 64 + dd);
            const f32x4 q = (f32x4){bflo(qw.x), bfhi(qw.x), bflo(qw.y), bfhi(qw.y)};
            float m = -1e30f, l = 0.f; f32x4 o = (f32x4){0.f, 0.f, 0.f, 0.f};
            sample_task(cache, newrows, lb, dil, qi, 512, 64 * t + dd, 256 + 64 * t + dd, q, m, l, o);
            o = o * (1.0f / l);
            u32x2 w; w.x = pk2(o[0], o[1]); w.y = pk2(o[2], o[3]);
            *(u32x2*)((bf16*)(ws + WS_OBG) + ((size_t)grp * TT + row) * 256 + t * 64 + dd) = w;
            if ((lane & 15) == 0) ((float*)(ws + WS_LSE))[((size_t)grp * TT + row) * 4 + t] = LN2 * (m + __builtin_amdgcn_logf(l));
        } else {
            const int v = task - 1536, half = v & 1, nq = v >> 1, n = nq >> 2, qi = nq & 3;
            const int kvh = t >> 1, qh = 4 * kvh + 2 * half + (t & 1);
            const float* cache = a.in[2] + (size_t)n * 128 * 256;
            const float* newrows = a.out + O_CA_S + (size_t)n * 4 * 256;
            const size_t row = (size_t)TP + nq;
            const u32x2 qw = *(const u32x2*)(P + row * NPROJ + qh * 64 + dd);
            const f32x4 q = (f32x4){bflo(qw.x), bfhi(qw.x), bflo(qw.y), bfhi(qw.y)};
            float m = a.in[8][qh] * LOG2E, l = 1.0f; f32x4 o = (f32x4){0.f, 0.f, 0.f, 0.f};
            sample_task(cache, newrows, 128, 1, qi, 256, 64 * kvh + dd, 128 + 64 * kvh + dd, q, m, l, o);
            o = o * (1.0f / l);
            u32x2 w; w.x = pk2(o[0], o[1]); w.y = pk2(o[2], o[3]);
            *(u32x2*)((bf16*)(ws + WS_OAB) + row * 768 + qh * 64 + dd) = w;
        }
    }
}
}


namespace sm {
__device__ __forceinline__ void tile_partial(const bf16* As, int lda, const bf16* Bt, int ldb, int K, int rb, int cb, int wave, int lane, f32x4 (&acc)[4][2]) {
    const int r = lane & 15, g = lane >> 4, kw = K >> 3;
    const bf16* ap = As + (size_t)(rb * 64 + r) * lda + wave * kw + 8 * g;
    const bf16* bp = Bt + (size_t)(cb * 32 + r) * ldb + wave * kw + 8 * g;
#pragma unroll 2
    for (int ks = 0; ks < kw; ks += 32) {
        bf16x8 af[4], bfr[2];
#pragma unroll
        for (int i = 0; i < 4; ++i) af[i] = *(const bf16x8*)(ap + (size_t)16 * i * lda + ks);
#pragma unroll
        for (int j = 0; j < 2; ++j) bfr[j] = *(const bf16x8*)(bp + (size_t)16 * j * ldb + ks);
#pragma unroll
        for (int i = 0; i < 4; ++i)
#pragma unroll
            for (int j = 0; j < 2; ++j) acc[i][j] = __builtin_amdgcn_mfma_f32_16x16x32_bf16(bfr[j], af[i], acc[i][j], 0, 0, 0);
    }
}
__device__ __forceinline__ f32x4 tile_reduce(LAS unsigned char* part, const f32x4 (&acc)[4][2], int rb, int cb, int tid, int wave, int lane, int& row, int& col) {
    LAS f32x4* pp = (LAS f32x4*)part;
#pragma unroll
    for (int i = 0; i < 4; ++i)
#pragma unroll
        for (int j = 0; j < 2; ++j) pp[(wave * 8 + i * 2 + j) * 64 + lane] = acc[i][j];
    __syncthreads();
    const int q = tid >> 6, ln = tid & 63;
    f32x4 sres = pp[q * 64 + ln];
#pragma unroll
    for (int w = 1; w < 8; ++w) sres = sres + pp[(w * 8 + q) * 64 + ln];
    row = rb * 64 + 16 * (q >> 1) + (ln & 15); col = cb * 32 + 16 * (q & 1) + 4 * (ln >> 4);
    return sres;
}
}

__device__ __forceinline__ void combine_pass(const Args& a, int gtid, int NGT) {
    unsigned char* ws = a.ws; const bf16* OBG = (const bf16*)(ws + WS_OBG); const float* LSE = (const float*)(ws + WS_LSE); bf16* OB = (bf16*)(ws + WS_OAB) + 512;
    for (int it = gtid; it < TT * 32; it += NGT) {
        const int row = it >> 5, c8 = (it & 31) * 8, slot = c8 >> 6;
        const float l0 = LSE[((size_t)0 * TT + row) * 4 + slot], l1 = LSE[((size_t)1 * TT + row) * 4 + slot], l2 = LSE[((size_t)2 * TT + row) * 4 + slot];
        const float mx = fmaxf(l0, fmaxf(l1, l2));
        float w0 = __expf(l0 - mx), w1 = __expf(l1 - mx), w2 = __expf(l2 - mx); const float inv = 1.0f / (w0 + w1 + w2); w0 *= inv; w1 *= inv; w2 *= inv;
        const u32x4 a0 = *(const u32x4*)(OBG + ((size_t)0 * TT + row) * 256 + c8), a1 = *(const u32x4*)(OBG + ((size_t)1 * TT + row) * 256 + c8), a2 = *(const u32x4*)(OBG + ((size_t)2 * TT + row) * 256 + c8);
        u32x4 r;
#pragma unroll
        for (int k = 0; k < 4; ++k) r[k] = pk2(w0 * bflo(a0[k]) + w1 * bflo(a1[k]) + w2 * bflo(a2[k]), w0 * bfhi(a0[k]) + w1 * bfhi(a1[k]) + w2 * bfhi(a2[k]));
        *(u32x4*)(OB + (size_t)row * 768 + c8) = r;
    }
}
__device__ __forceinline__ void ln_row(const float* zr, const float* gam, const float* bet, int lane, f32x4 (&y)[4]) {
    const f32x4* z4 = (const f32x4*)zr + lane; f32x4 v[4]; float s = 0.f;
#pragma unroll
    for (int j = 0; j < 4; ++j) { v[j] = z4[64 * j]; s += (v[j][0] + v[j][1]) + (v[j][2] + v[j][3]); }
    const float mean = wave_sum(s) * (1.f / DM); float s2 = 0.f;
#pragma unroll
    for (int j = 0; j < 4; ++j) { v[j] = v[j] - mean; s2 += (v[j][0] * v[j][0] + v[j][1] * v[j][1]) + (v[j][2] * v[j][2] + v[j][3] * v[j][3]); }
    const float rstd = 1.f / sqrtf(wave_sum(s2) * (1.f / DM) + LN_EPS);
#pragma unroll
    for (int j = 0; j < 4; ++j) { const f32x4 gv = ((const f32x4*)gam + lane)[64 * j], bv = ((const f32x4*)bet + lane)[64 * j]; y[j] = v[j] * rstd * gv + bv; }
}
__device__ __forceinline__ void ln1_pass(const Args& a, int gw, int NGW, int lane) {
    const float* Z = (const float*)(a.ws + WS_Z1); bf16* HB = (bf16*)(a.ws + WS_HB);
    for (int m = gw; m < TT; m += NGW) {
        f32x4 y[4]; ln_row(Z + (size_t)m * DM, a.in[12], a.in[13], lane, y);
        unsigned long long* o8 = (unsigned long long*)(HB + (size_t)m * DM) + lane;
#pragma unroll
        for (int j = 0; j < 4; ++j) o8[64 * j] = (unsigned long long)pk2(y[j][0], y[j][1]) | ((unsigned long long)pk2(y[j][2], y[j][3]) << 32);
    }
}
__device__ __forceinline__ void ln2_pass(const Args& a, int gw, int NGW, int lane) {
    for (int m = gw; m < TT; m += NGW) {
        float* yr = a.out + (size_t)m * DM;
        f32x4 y[4]; ln_row(yr, a.in[18], a.in[19], lane, y);
#pragma unroll
        for (int j = 0; j < 4; ++j) ((f32x4*)yr + lane)[64 * j] = y[j];
    }
}
__device__ __forceinline__ float gelu_exact(float x) { return 0.5f * x * (1.0f + erff(x * 0.70710678118654752f)); }
__device__ __forceinline__ void conv_pass(const Args& a, int gtid, int NGT) {
    const bf16* UV = (const bf16*)(a.ws + WS_UV); bf16* G = (bf16*)(a.ws + WS_G);
    const float* cw = a.in[15]; const float* cb = a.in[16]; const float* st = a.in[6];
    for (int it = gtid; it < TT * (FF / 8); it += NGT) {
        const int row = it / (FF / 8), c = (it % (FF / 8)) * 8;
        const int uc = ((c >> 7) << 8) + (c & 127);
        const u32x4 u0 = *(const u32x4*)(UV + (size_t)row * NUP + uc), vv = *(const u32x4*)(UV + (size_t)row * NUP + uc + 128);
        float u1[8], u2[8];
        int tpos; const float* s1 = nullptr; const float* s2 = nullptr;
        if (row < TP) tpos = row & (SEQ - 1); else { tpos = row & 3; const int n = (row - TP) >> 2; s2 = st + ((size_t)n * 2 + 0) * FF + c; s1 = st + ((size_t)n * 2 + 1) * FF + c; }
        if (tpos >= 1) { const u32x4 w = *(const u32x4*)(UV + (size_t)(row - 1) * NUP + uc);
#pragma unroll
            for (int k = 0; k < 4; ++k) { u1[2 * k] = bflo(w[k]); u1[2 * k + 1] = bfhi(w[k]); } }
        else {
#pragma unroll
            for (int k = 0; k < 8; ++k) u1[k] = s1 ? s1[k] : 0.f; }
        if (tpos >= 2) { const u32x4 w = *(const u32x4*)(UV + (size_t)(row - 2) * NUP + uc);
#pragma unroll
            for (int k = 0; k < 4; ++k) { u2[2 * k] = bflo(w[k]); u2[2 * k + 1] = bfhi(w[k]); } }
        else if (tpos == 1) {
#pragma unroll
            for (int k = 0; k < 8; ++k) u2[k] = s1 ? s1[k] : 0.f; }
        else {
#pragma unroll
            for (int k = 0; k < 8; ++k) u2[k] = s2 ? s2[k] : 0.f; }
        u32x4 r;
#pragma unroll
        for (int k = 0; k < 4; ++k) {
            const int c0 = c + 2 * k, c1 = c0 + 1;
            const float a0 = cw[c0] * u2[2 * k] + cw[FF + c0] * u1[2 * k] + cw[2 * FF + c0] * bflo(u0[k]) + cb[c0];
            const float a1 = cw[c1] * u2[2 * k + 1] + cw[FF + c1] * u1[2 * k + 1] + cw[2 * FF + c1] * bfhi(u0[k]) + cb[c1];
            r[k] = pk2(gelu_exact(a0) * bflo(vv[k]), gelu_exact(a1) * bfhi(vv[k]));
        }
        *(u32x4*)(G + (size_t)row * FF + c) = r;
    }
}

__global__ void __launch_bounds__(NTHREADS, 2) fwd_kernel(Args args) {
    extern __shared__ __attribute__((aligned(16))) unsigned char lds_raw[];
    LAS unsigned char* lds = (LAS unsigned char*)lds_raw;
    const int tid = threadIdx.x, lane = tid & 63, wave = __builtin_amdgcn_readfirstlane(tid >> 6);
    const int G = gridDim.x, bx = blockIdx.x;
    const int vcu = (G % 8 == 0) ? (bx % 8) * (G / 8) + bx / 8 : bx;
    const int gw = vcu * NWAVES + wave, NGW = G * NWAVES, gtid = vcu * NTHREADS + tid, NGT = G * NTHREADS;
    unsigned char* ws = args.ws;
    const int lo = args.ph_lo, hi = args.ph_hi;
#ifndef PHMASK
#define PHMASK 0xfff
#endif
#define IN(k) (((PHMASK >> (k)) & 1) && lo <= (k) && (k) < hi)
#ifndef REPMASK
#define REPMASK 0
#endif
#define REPS(k) ((((REPMASK) >> (k)) & 1) ? 2 : 1)
#define SEAM(k) do { if (IN(k) && IN((k) + 1)) { cg::this_grid().sync(); } } while (0)

    if (IN(0)) for (int rep_ = 0; rep_ < REPS(0); ++rep_) { p0_prologue(args, lds, gw, NGW, wave, lane); }
    SEAM(0);
    if (IN(1)) for (int rep_ = 0; rep_ < REPS(1); ++rep_) {
        pg8::Gemm g{(const pg8::bf16_t*)(ws + WS_XB), (const pg8::bf16_t*)(ws + WS_WIN), TT, NPROJ, DM}; pg8::StaticOrder S; S.init(TT, NPROJ, G, bx);
        pg8::EpiProj E{(pg8::bf16_t*)(ws + WS_PROJ), (const float*)(ws + WS_ROPE), args.out};
        pg8::gemm_phase<pg8::EpiProj, pg8::StaticOrder, true, true>(lds, g, S, E);
    }
    SEAM(1);
    if (IN(2)) for (int rep_ = 0; rep_ < REPS(2); ++rep_) {
        for (int i = tid; i < 16 * att::KP / 4; i += NTHREADS) { ((LAS unsigned*)(lds + att::LDS_K + 256 * att::KP))[i] = 0u; ((LAS unsigned*)(lds + att::LDS_V + 256 * att::KP))[i] = 0u; }
#ifndef REP_PROMPT
#define REP_PROMPT 1
#endif
#ifndef REP_SAMPLE
#define REP_SAMPLE 1
#endif
        for (int rep = 0; rep < REP_PROMPT; ++rep)
        for (int u = vcu; u < 1792; u += G) att::prompt_unit(args, lds, u, tid, wave, lane);
        for (int rep = 0; rep < REP_SAMPLE; ++rep)
        att::sample_tasks(args, gw, NGW, lane);
        __syncthreads();
    }
    SEAM(2);
    if (IN(3)) for (int rep_ = 0; rep_ < REPS(3); ++rep_) { combine_pass(args, gtid, NGT); }
    SEAM(3);
    if (IN(4)) for (int rep_ = 0; rep_ < REPS(4); ++rep_) {
        {
            pg8::Gemm g{(const pg8::bf16_t*)(ws + WS_OAB), (const pg8::bf16_t*)(ws + WS_WBR), TP, DM, 768}; pg8::StaticOrder S; S.init(TP, DM, G, bx);
            pg8::EpiGateM E{(const pg8::bf16_t*)(ws + WS_PROJ), (pg8::bf16_t*)(ws + WS_M)};
            pg8::gemm_phase<pg8::EpiGateM, pg8::StaticOrder, true, true>(lds, g, S, E);
        }
        for (int su = vcu; su < 256; su += G) {
            const int rb = su >> 5, cb = su & 31;
            const bf16* As = (const bf16*)(ws + WS_OAB) + (size_t)TP * 768; const bf16* Bt = (const bf16*)(ws + WS_WBR);
            f32x4 accA[4][2], accB[4][2];
#pragma unroll
            for (int i = 0; i < 4; ++i)
#pragma unroll
                for (int j = 0; j < 2; ++j) { accA[i][j] = (f32x4){0.f, 0.f, 0.f, 0.f}; accB[i][j] = accA[i][j]; }
            sm::tile_partial(As, 768, Bt, 768, 512, rb, cb, wave, lane, accA);
            sm::tile_partial(As + 512, 768, Bt + 512, 768, 256, rb, cb, wave, lane, accB);
            int row, col;
            __syncthreads();
            const f32x4 sa = sm::tile_reduce(lds, accA, rb, cb, tid, wave, lane, row, col);
            const f32x4 sb = sm::tile_reduce(lds + 65536, accB, rb, cb, tid, wave, lane, row, col);
            const bf16* pr = (const bf16*)(ws + WS_PROJ) + (size_t)(TP + row) * NPROJ;
            const u32x2 ga = *(const u32x2*)(pr + 3072 + col), gb = *(const u32x2*)(pr + 4096 + col);
            f32x4 mv;
            mv[0] = pg8::sigmoidf_(bflo(ga.x)) * sa[0] + pg8::sigmoidf_(bflo(gb.x)) * sb[0]; mv[1] = pg8::sigmoidf_(bfhi(ga.x)) * sa[1] + pg8::sigmoidf_(bfhi(gb.x)) * sb[1];
            mv[2] = pg8::sigmoidf_(bflo(ga.y)) * sa[2] + pg8::sigmoidf_(bflo(gb.y)) * sb[2]; mv[3] = pg8::sigmoidf_(bfhi(ga.y)) * sa[3] + pg8::sigmoidf_(bfhi(gb.y)) * sb[3];
            u32x2 w; w.x = pk2(mv[0], mv[1]); w.y = pk2(mv[2], mv[3]);
            *(u32x2*)((bf16*)(ws + WS_M) + (size_t)(TP + row) * DM + col) = w;
        }
        __syncthreads();
    }
    SEAM(4);
    if (IN(5)) for (int rep_ = 0; rep_ < REPS(5); ++rep_) { }
    if (IN(6)) for (int rep_ = 0; rep_ < REPS(6); ++rep_) {
        {
            pg8::Gemm g{(const pg8::bf16_t*)(ws + WS_M), (const pg8::bf16_t*)(ws + WS_WO), TP, DM, DM}; pg8::StaticOrder S; S.init(TP, DM, G, bx);
            pg8::EpiZ1 E{args.in[0], args.in[1], (float*)(ws + WS_Z1)};
            pg8::gemm_phase<pg8::EpiZ1, pg8::StaticOrder, true, true>(lds, g, S, E);
        }
        for (int su = vcu; su < 256; su += G) {
            const int rb = su >> 5, cb = su & 31;
            f32x4 acc[4][2];
#pragma unroll
            for (int i = 0; i < 4; ++i)
#pragma unroll
                for (int j = 0; j < 2; ++j) acc[i][j] = (f32x4){0.f, 0.f, 0.f, 0.f};
            sm::tile_partial((const bf16*)(ws + WS_M) + (size_t)TP * DM, DM, (const bf16*)(ws + WS_WO), DM, DM, rb, cb, wave, lane, acc);
            int row, col;
            __syncthreads();
            const f32x4 sv = sm::tile_reduce(lds, acc, rb, cb, tid, wave, lane, row, col);
            const f32x4 xv = *(const f32x4*)(args.in[1] + (size_t)row * DM + col);
            *(f32x4*)((float*)(ws + WS_Z1) + (size_t)(TP + row) * DM + col) = xv * ALPHA + sv;
        }
        __syncthreads();
    }
    SEAM(6);
    if (IN(7)) for (int rep_ = 0; rep_ < REPS(7); ++rep_) { ln1_pass(args, gw, NGW, lane); }
    SEAM(7);
    if (IN(8)) for (int rep_ = 0; rep_ < REPS(8); ++rep_) {
        pg8::Gemm g{(const pg8::bf16_t*)(ws + WS_HB), (const pg8::bf16_t*)(ws + WS_WUP), TT, NUP, DM}; pg8::ConvOrder S; S.init(G, bx);
        pg8::EpiConv E{(pg8::bf16_t*)(ws + WS_G), args.out, args.in[15], args.in[16], args.in[6], (unsigned long long*)(ws + WS_HALO), (LAS float*)(lds + RING_BYTES)};
        pg8::gemm_phase<pg8::EpiConv, pg8::ConvOrder, true, true>(lds, g, S, E);
    }
    if (IN(9)) for (int rep_ = 0; rep_ < REPS(9); ++rep_) { }
    SEAM(9);
    if (IN(10)) for (int rep_ = 0; rep_ < REPS(10); ++rep_) {
        {
            pg8::Gemm g{(const pg8::bf16_t*)(ws + WS_G), (const pg8::bf16_t*)(ws + WS_WDN), TP, DM, FF}; pg8::StaticOrder S; S.init(TP, DM, G, bx);
            pg8::EpiZ2 E{(const pg8::bf16_t*)(ws + WS_HB), args.out};
            pg8::gemm_phase<pg8::EpiZ2, pg8::StaticOrder, true, true>(lds, g, S, E);
        }
        for (int su = vcu; su < 256; su += G) {
            const int rb = su >> 5, cb = su & 31;
            f32x4 acc[4][2];
#pragma unroll
            for (int i = 0; i < 4; ++i)
#pragma unroll
                for (int j = 0; j < 2; ++j) acc[i][j] = (f32x4){0.f, 0.f, 0.f, 0.f};
            sm::tile_partial((const bf16*)(ws + WS_G) + (size_t)TP * FF, FF, (const bf16*)(ws + WS_WDN), FF, FF, rb, cb, wave, lane, acc);
            int row, col;
            __syncthreads();
            const f32x4 sv = sm::tile_reduce(lds, acc, rb, cb, tid, wave, lane, row, col);
            const u32x2 hw = *(const u32x2*)((const bf16*)(ws + WS_HB) + (size_t)(TP + row) * DM + col);
            const f32x4 hv = (f32x4){bflo(hw.x), bfhi(hw.x), bflo(hw.y), bfhi(hw.y)};
            *(f32x4*)(args.out + (size_t)(TP + row) * DM + col) = hv * ALPHA + sv;
        }
        __syncthreads();
    }
    SEAM(10);
    if (IN(11)) for (int rep_ = 0; rep_ < REPS(11); ++rep_) { ln2_pass(args, gw, NGW, lane); }
#undef IN
#undef SEAM
}

#ifndef N_LAUNCH_MODE
#define N_LAUNCH_MODE 1
#endif
extern "C" void kernel_launch(void* const* d_in, const int* in_sizes, int n_in, void* d_out, int out_size, void* d_ws, size_t ws_size, hipStream_t stream) {
    static int grid = 0;
    if (grid == 0) {
        if (n_in != 20 || (size_t)out_size != O_END || ws_size < WS_END) { fprintf(stderr, "kernel_launch: unexpected shapes: n_in %d out %d ws %zu\n", n_in, out_size, ws_size); grid = -1; return; }
        int dev = 0, cus = 0, per_cu = 0;
        if (hipGetDevice(&dev) != hipSuccess || hipDeviceGetAttribute(&cus, hipDeviceAttributeMultiprocessorCount, dev) != hipSuccess) { grid = -1; return; }
        if (hipFuncSetAttribute((const void*)fwd_kernel, hipFuncAttributeMaxDynamicSharedMemorySize, LDS_BYTES) != hipSuccess) { fprintf(stderr, "kernel_launch: hipFuncSetAttribute failed\n"); grid = -1; return; }
        if (hipOccupancyMaxActiveBlocksPerMultiprocessor(&per_cu, (const void*)fwd_kernel, NTHREADS, LDS_BYTES) != hipSuccess || per_cu < 1) { fprintf(stderr, "kernel_launch: occupancy query says %d\n", per_cu); per_cu = 1; }
        (void)hipGetLastError();
        grid = cus;
        if (grid != 256) { fprintf(stderr, "kernel_launch: this kernel needs exactly 256 CUs (got %d)\n", grid); grid = -1; return; }
    }
    if (grid < 0) return;
    Args a{};
    for (int i = 0; i < 20; ++i) a.in[i] = (const float*)d_in[i];
    a.out = (float*)d_out; a.ws = (unsigned char*)d_ws;
    for (int d = 0; d < 32; ++d) a.inv_freq[d] = pow(10000.0, -(double)d / 32.0);
    if (N_LAUNCH_MODE == 1) {
        a.ph_lo = 0; a.ph_hi = NPHASE; a.coop = 1;
        void* kargs[] = {&a};
#ifndef HOST_REPEAT
#define HOST_REPEAT 1
#endif
        hipError_t e = hipSuccess;
        for (int rr = 0; rr < HOST_REPEAT; ++rr) e = hipLaunchCooperativeKernel((const void*)fwd_kernel, dim3(grid), dim3(NTHREADS), kargs, LDS_BYTES, stream);
#ifdef PREFIX_K
        a.ph_lo = 0; a.ph_hi = PREFIX_K; e = hipLaunchCooperativeKernel((const void*)fwd_kernel, dim3(grid), dim3(NTHREADS), kargs, LDS_BYTES, stream);
#endif
        if (e != hipSuccess) fprintf(stderr, "kernel_launch: cooperative launch failed: %s (grid %d)\n", hipGetErrorString(e), grid);
    } else {
        for (int p = 0; p < NPHASE; ++p) {
            a.ph_lo = p; a.ph_hi = p + 1; a.coop = 0;
            hipLaunchKernelGGL(fwd_kernel, dim3(grid), dim3(NTHREADS), LDS_BYTES, stream, a);
        }
    }
}
```
